# Optimizing an MI355X kernel written in HIP

```python
import jax, jax.numpy as jnp
from jax import lax
import numpy as np

D_MODEL = 1024
BATCH = 8
SEQ = 4096
DEPTH = 4

N_A = DEPTH // 2
N_B = DEPTH - N_A
HEAD_DIM = 64
MIX_WIDTH = D_MODEL
MEM_LEN = 256
MEM_HEADS = 4
MEM_WIDTH = MEM_HEADS * HEAD_DIM
MAIN_WIDTH = MIX_WIDTH - MEM_WIDTH
POOL_WINDOWS = (2, 4, 8, 16)
POOL_GROUPS = len(POOL_WINDOWS)
POOL_GROUP_DIM = MAIN_WIDTH // POOL_GROUPS
SWA_Q_HEADS = MAIN_WIDTH // HEAD_DIM
SWA_KV_HEADS = 4
SWA_GROUP = SWA_Q_HEADS // SWA_KV_HEADS
KV_WIDTH = 2 * SWA_KV_HEADS * HEAD_DIM
MEM_KV_WIDTH = 2 * MEM_WIDTH
WINDOW = 128
BLOCK = 128
D_FF = 4 * D_MODEL
EPS = 1e-6

kernel_name = "yoco_pool_swa_sink_hybrid"


def rmsnorm(x, g):
    xf = x.astype(jnp.float32)
    y = xf * lax.rsqrt(jnp.mean(xf * xf, axis=-1, keepdims=True) + EPS)
    return (y * g.astype(jnp.float32)).astype(x.dtype)


def alibi_slopes(n):
    return jnp.exp2(-8.0 * jnp.arange(1, n + 1, dtype=jnp.float32) / n)


def pool_mixer(u, pool_w, pool_scale):
    B, S, _ = u.shape
    uf = u.astype(jnp.float32).reshape(B, S, POOL_GROUPS, POOL_GROUP_DIM)
    csum = jnp.concatenate([jnp.zeros((B, 1, POOL_GROUPS, POOL_GROUP_DIM), jnp.float32),
                            jnp.cumsum(uf, axis=1)], axis=1)
    win = jnp.array(POOL_WINDOWS, jnp.int32)
    t = jnp.arange(S, dtype=jnp.int32)[:, None]
    lo = jnp.maximum(t + 1 - win[None, :], 0)
    cnt = jnp.minimum(t + 1, win[None, :]).astype(jnp.float32)
    window_sum = csum[:, 1:] - csum[:, lo, jnp.arange(POOL_GROUPS)[None, :]]
    d = (window_sum / cnt[None, :, :, None] - uf).astype(u.dtype)
    mixed = jnp.einsum('bsgc,gcd->bsgd', d, pool_w)
    return mixed.reshape(B, S, MAIN_WIDTH) * pool_scale


def swa_sink_attention(q, k, v, sinks):
    B, S = q.shape[0], q.shape[1]
    nb = S // BLOCK
    qb = q.reshape(B, nb, BLOCK, SWA_KV_HEADS, SWA_GROUP, HEAD_DIM)

    def with_prev(a):
        ab = a.reshape(B, nb, BLOCK, SWA_KV_HEADS, HEAD_DIM)
        prev = jnp.pad(ab[:, :-1], ((0, 0), (1, 0), (0, 0), (0, 0), (0, 0)))
        return jnp.concatenate([prev, ab], axis=2)

    kb, vb = with_prev(k), with_prev(v)
    s = jnp.einsum('bnqkgd,bnpkd->bnkgqp', qb, kb).astype(jnp.float32) * (HEAD_DIM ** -0.5)
    blk = jnp.arange(nb, dtype=jnp.int32)[:, None] * BLOCK
    qpos = blk + jnp.arange(BLOCK, dtype=jnp.int32)[None, :]
    kpos = blk - BLOCK + jnp.arange(2 * BLOCK, dtype=jnp.int32)[None, :]
    dist = qpos[:, :, None] - kpos[:, None, :]
    valid = (dist >= 0) & (dist < WINDOW) & (kpos[:, None, :] >= 0)
    slopes = alibi_slopes(SWA_Q_HEADS).reshape(SWA_KV_HEADS, SWA_GROUP)
    s = s - slopes[None, None, :, :, None, None] * dist.astype(jnp.float32)[None, :, None, None]
    s = jnp.where(valid[None, :, None, None], s, jnp.finfo(jnp.float32).min)
    sink = sinks.astype(jnp.float32).reshape(SWA_KV_HEADS, SWA_GROUP)[None, None, :, :, None, None]
    m = jnp.maximum(jnp.max(s, axis=-1, keepdims=True), sink)
    e = jnp.exp(s - m)
    p = e / (jnp.sum(e, axis=-1, keepdims=True) + jnp.exp(sink - m))
    o = jnp.einsum('bnkgqp,bnpkd->bnqkgd', p.astype(vb.dtype), vb)
    return o.reshape(B, S, SWA_Q_HEADS * HEAD_DIM)


def memory_attention(q, mk, mv):
    s = jnp.einsum('bshd,bmhd->bhsm', q, mk).astype(jnp.float32) * (HEAD_DIM ** -0.5)
    p = jax.nn.softmax(s, axis=-1)
    o = jnp.einsum('bhsm,bmhd->bshd', p.astype(mv.dtype), mv)
    return o.reshape(q.shape[0], q.shape[1], MEM_WIDTH)


def sq_relu_mlp(x, w_up, w_down):
    h = jax.nn.relu(x @ w_up)
    return (h * h) @ w_down


def setup_inputs(seed: int = 0) -> dict:
    key = jax.random.key(seed)
    ks = jax.random.split(key, 20)
    f32 = jnp.float32

    def nrm(k, shape, scale):
        return jax.random.normal(k, shape, f32) * scale

    def gain(k, shape):
        return 1.0 + 0.02 * jax.random.normal(k, shape, f32)

    return {
        "x": nrm(ks[0], (BATCH, SEQ, D_MODEL), 1.0),
        "mem": nrm(ks[1], (BATCH, MEM_LEN, D_MODEL), 1.0),
        "norm_mix": gain(ks[2], (DEPTH, D_MODEL)),
        "w_in": nrm(ks[3], (DEPTH, D_MODEL, MIX_WIDTH), D_MODEL ** -0.5),
        "pool_w": nrm(ks[4], (N_A, POOL_GROUPS, POOL_GROUP_DIM, POOL_GROUP_DIM), POOL_GROUP_DIM ** -0.5),
        "pool_scale": gain(ks[5], (N_A, MAIN_WIDTH)),
        "kv_norm": gain(ks[6], (D_MODEL,)),
        "w_kv": nrm(ks[7], (D_MODEL, KV_WIDTH), D_MODEL ** -0.5),
        "k_norm": gain(ks[8], (HEAD_DIM,)),
        "q_norm": gain(ks[9], (N_B, HEAD_DIM)),
        "sinks": nrm(ks[10], (N_B, SWA_Q_HEADS), 0.5),
        "mem_norm": gain(ks[11], (DEPTH, D_MODEL)),
        "w_mem_kv": nrm(ks[12], (DEPTH, D_MODEL, MEM_KV_WIDTH), D_MODEL ** -0.5),
        "mem_q_norm": gain(ks[13], (DEPTH, HEAD_DIM)),
        "mem_k_norm": gain(ks[14], (DEPTH, HEAD_DIM)),
        "w_out": nrm(ks[15], (DEPTH, MIX_WIDTH, D_MODEL), MIX_WIDTH ** -0.5),
        "norm_mlp": gain(ks[16], (DEPTH, D_MODEL)),
        "w_up": nrm(ks[17], (DEPTH, D_MODEL, D_FF), D_MODEL ** -0.5),
        "w_down": nrm(ks[18], (DEPTH, D_FF, D_MODEL), D_FF ** -0.5),
    }


def reference(x, mem, norm_mix, w_in, pool_w, pool_scale, kv_norm, w_kv, k_norm, q_norm, sinks,
              mem_norm, w_mem_kv, mem_q_norm, mem_k_norm, w_out, norm_mlp, w_up, w_down):
    B, S, _ = x.shape
    h = x
    k_shared = None
    v_shared = None
    for l in range(DEPTH):
        if l == N_A:
            kv = rmsnorm(h, kv_norm) @ w_kv
            k_shared = rmsnorm(kv[..., :KV_WIDTH // 2].reshape(B, S, SWA_KV_HEADS, HEAD_DIM), k_norm)
            v_shared = kv[..., KV_WIDTH // 2:].reshape(B, S, SWA_KV_HEADS, HEAD_DIM)

        proj = rmsnorm(h, norm_mix[l]) @ w_in[l]
        main, mq = proj[..., :MAIN_WIDTH], proj[..., MAIN_WIDTH:]
        if l < N_A:
            main_out = pool_mixer(main, pool_w[l], pool_scale[l])
        else:
            j = l - N_A
            q = rmsnorm(main.reshape(B, S, SWA_Q_HEADS, HEAD_DIM), q_norm[j])
            main_out = swa_sink_attention(q, k_shared, v_shared, sinks[j])

        mkv = rmsnorm(mem, mem_norm[l]) @ w_mem_kv[l]
        mk = rmsnorm(mkv[..., :MEM_WIDTH].reshape(B, MEM_LEN, MEM_HEADS, HEAD_DIM), mem_k_norm[l])
        mv = mkv[..., MEM_WIDTH:].reshape(B, MEM_LEN, MEM_HEADS, HEAD_DIM)
        mqh = rmsnorm(mq.reshape(B, S, MEM_HEADS, HEAD_DIM), mem_q_norm[l])
        mem_out = memory_attention(mqh, mk, mv)

        h = h + jnp.concatenate([main_out, mem_out], axis=-1) @ w_out[l]
        h = h + sq_relu_mlp(rmsnorm(h, norm_mlp[l]), w_up[l], w_down[l])
    return h
```

```cpp
#include <hip/hip_runtime.h>
#include <hip/hip_cooperative_groups.h>
#include <cstdio>
#include <cstdint>
namespace cg = cooperative_groups;
namespace pg8 {
#define PG8_LAS __attribute__((address_space(3)))
typedef unsigned short bf16_t;
typedef short bf16x8 __attribute__((ext_vector_type(8)));
typedef float f32x4 __attribute__((ext_vector_type(4)));
typedef unsigned u32x4 __attribute__((ext_vector_type(4)));
constexpr int BM = 256, BK = 64, HALF = 128, HTB = HALF * BK * 2  , STAGE_BYTES = 8 * HTB, NXCD = 8, WGM = 8;

__host__ __device__ __forceinline__ int lds_byte(int r, int c) { const int st = (r >> 4) * 2 + (c >> 5), rr = r & 15, cc = c & 31, ob = rr * 64 + cc * 2; return st * 1024 + (ob ^ (((ob >> 9) & 1) << 5)); }
__host__ __device__ __forceinline__ void stage_rc(int b, int& R, int& C) { const int st = b / 1024, sb = b % 1024, swz = sb ^ (((sb >> 9) & 1) << 5); R = (st >> 1) * 16 + swz / 64; C = (st & 1) * 32 + (swz % 64) / 2; }
__host__ __device__ __forceinline__ int perm32(int rho) { const int n = rho >> 4, i = rho & 15; return 8 * (i >> 2) + 4 * n + (i & 3); }

struct Unit { int pm, pn; };
struct Gemm { const bf16_t* A; const bf16_t* Bt; int M, N, K; };

struct StaticOrder {
    int nM, nN, nwg, G, c;
    __host__ __device__ void init(int M, int N, int G_, int c_) { nM = M / BM; nN = N / BM; nwg = nM * nN; G = G_; c = c_; }
    __host__ __device__ bool next(int i, Unit& u) const {
        const long L = (long)i * G + c; if (L >= nwg) return false;
        int wgid = (int)L; { const int q = nwg / NXCD, r = nwg % NXCD, xcd = wgid % NXCD, off = wgid / NXCD; wgid = (xcd < r ? xcd * (q + 1) : r * (q + 1) + (xcd - r) * q) + off; }
        const int nig = WGM * nN, gid = wgid / nig, fm = gid * WGM, gsz = (nM - fm) < WGM ? (nM - fm) : WGM;
        u.pm = fm + ((wgid % nig) % gsz); u.pn = (wgid % nig) / gsz; return true;
    }
    __device__ __forceinline__ void a_ready(const Unit&) const {}
    __device__ __forceinline__ void done(const Unit&) const {}
};

typedef float f32x2 __attribute__((ext_vector_type(2)));
typedef __bf16 bf16x2_t __attribute__((ext_vector_type(2)));
__device__ __forceinline__ unsigned cvt_pk_bf16(float lo, float hi) { f32x2 v = {lo, hi}; bf16x2_t b = __builtin_convertvector(v, bf16x2_t); return __builtin_bit_cast(unsigned, b); }
__device__ __forceinline__ float bflo(unsigned u) { return __builtin_bit_cast(float, u << 16); }
__device__ __forceinline__ float bfhi(unsigned u) { return __builtin_bit_cast(float, u & 0xffff0000u); }

#ifndef EPI_ST
#define EPI_ST 0
#endif
__device__ __forceinline__ void st16(void* p, u32x4 v) {
#if EPI_ST == 1
    asm volatile("global_store_dwordx4 %0, %1, off sc1\n\ts_nop 1" :: "v"(p), "v"(v) : "memory");
#elif EPI_ST == 2
    __builtin_nontemporal_store(v, (u32x4*)p);
#else
    *(u32x4*)p = v;
#endif
}
__device__ __forceinline__ float relu_f(float x) { float y; asm("v_max_f32_e32 %0, 0, %1" : "=v"(y) : "v"(x)); return y; }
struct EpiB {
    static constexpr bool PERM = true, AFTER_DRAIN = false, WIDE = true;
    static constexpr int SCR_PITCH = 144, SCR_BYTES = 16 * SCR_PITCH;
    bf16_t* O1; int ldc1; bf16_t* O2; int ldc2; int split_pn; int mode; const float* ssq_in; float* ssq_out; float* outf; PG8_LAS unsigned char* scr;
    template <int MODE>
    __device__ __forceinline__ void body(const f32x4 (&acc)[2][2][4][2], bf16_t* base, int ldc, int rowt, int colw, const float (&rs)[2][4], int pn, int wr, int wc, int fr, int fq) const {
        const int col0 = colw + 8 * fq;
        if (MODE == 3) {
            PG8_LAS unsigned char* wscr3 = scr + (wr * 4 + wc) * SCR_BYTES;
            const int lane3 = fr + 16 * fq, rr3 = lane3 >> 3, ch3 = lane3 & 7;
#pragma unroll
            for (int ai = 0; ai < 2; ++ai)
#pragma unroll
                for (int m = 0; m < 4; ++m) {
                    const int rowg = rowt + ai * HALF + wr * 64 + m * 16;
                    const u32x4 hl0 = *(const u32x4*)(base + (size_t)(rowg + rr3) * ldc + colw + 8 * ch3), hl1 = *(const u32x4*)(base + (size_t)(rowg + 8 + rr3) * ldc + colw + 8 * ch3);
                    *(PG8_LAS u32x4*)(wscr3 + rr3 * SCR_PITCH + ch3 * 16) = hl0; *(PG8_LAS u32x4*)(wscr3 + (rr3 + 8) * SCR_PITCH + ch3 * 16) = hl1;
                    u32x4 hb[2]; hb[0] = *(const PG8_LAS u32x4*)(wscr3 + fr * SCR_PITCH + fq * 16); hb[1] = *(const PG8_LAS u32x4*)(wscr3 + fr * SCR_PITCH + fq * 16 + 64);
#pragma unroll
                    for (int bj = 0; bj < 2; ++bj) {
                        const u32x4 h = hb[bj];
                        f32x4 v0 = acc[ai][bj][m][0] * rs[ai][m], v1 = acc[ai][bj][m][1] * rs[ai][m];
                        v0[0] += bflo(h.x); v0[1] += bfhi(h.x); v0[2] += bflo(h.y); v0[3] += bfhi(h.y);
                        v1[0] += bflo(h.z); v1[1] += bfhi(h.z); v1[2] += bflo(h.w); v1[3] += bfhi(h.w);
                        *(PG8_LAS f32x4*)(wscr3 + fr * SCR_PITCH + fq * 32) = v0; *(PG8_LAS f32x4*)(wscr3 + fr * SCR_PITCH + fq * 32 + 16) = v1;
                        const f32x4 o0 = *(const PG8_LAS f32x4*)(wscr3 + rr3 * SCR_PITCH + ch3 * 16), o1 = *(const PG8_LAS f32x4*)(wscr3 + (rr3 + 8) * SCR_PITCH + ch3 * 16);
                        float* op = outf + (size_t)(rowg + rr3) * ldc + colw + 32 * bj + 4 * ch3;
                        *(f32x4*)op = o0; *(f32x4*)(op + (size_t)8 * ldc) = o1;
                    }
                }
            return;
        }
        PG8_LAS unsigned char* wscr = scr + (wr * 4 + wc) * SCR_BYTES;
        PG8_LAS unsigned char* wp = wscr + fr * SCR_PITCH + fq * 16;
        const int lane = fr + 16 * fq, rr = lane >> 3, ch = lane & 7;
        const PG8_LAS unsigned char* rp = wscr + rr * SCR_PITCH + ch * 16;
#pragma unroll
        for (int ai = 0; ai < 2; ++ai) {
            u32x4 hl[4][2];
            if (MODE == 2) {
#pragma unroll
                for (int m = 0; m < 4; ++m)
#pragma unroll
                    for (int k = 0; k < 2; ++k) hl[m][k] = *(const u32x4*)(base + (size_t)(rowt + ai * HALF + wr * 64 + m * 16 + 8 * k + rr) * ldc + colw + 8 * ch);
            }
#pragma unroll
            for (int m = 0; m < 4; ++m) {
                const int rowg = rowt + ai * HALF + wr * 64 + m * 16;
                float ss = 0.f;
                u32x4 hb[2];
                if (MODE == 2) {
                    *(PG8_LAS u32x4*)(wscr + rr * SCR_PITCH + ch * 16) = hl[m][0]; *(PG8_LAS u32x4*)(wscr + (rr + 8) * SCR_PITCH + ch * 16) = hl[m][1];
                    hb[0] = *(const PG8_LAS u32x4*)wp; hb[1] = *(const PG8_LAS u32x4*)(wp + 64);
                }
#pragma unroll
                for (int bj = 0; bj < 2; ++bj) {
                    f32x4 v0 = acc[ai][bj][m][0], v1 = acc[ai][bj][m][1];
                    if (MODE == 0) { v0 = v0 * rs[ai][m]; v1 = v1 * rs[ai][m]; }
                    else if (MODE == 1) {
#pragma unroll
                        for (int e = 0; e < 4; ++e) { const float x = relu_f(v0[e]); v0[e] = x * x; const float y = relu_f(v1[e]); v1[e] = y * y; } }
                    else { const u32x4 h = hb[bj]; v0 = v0 * rs[ai][m]; v1 = v1 * rs[ai][m];
                        v0[0] += bflo(h.x); v0[1] += bfhi(h.x); v0[2] += bflo(h.y); v0[3] += bfhi(h.y);
                        v1[0] += bflo(h.z); v1[1] += bfhi(h.z); v1[2] += bflo(h.w); v1[3] += bfhi(h.w); }
                    u32x4 w; w.x = cvt_pk_bf16(v0[0], v0[1]); w.y = cvt_pk_bf16(v0[2], v0[3]); w.z = cvt_pk_bf16(v1[0], v1[1]); w.w = cvt_pk_bf16(v1[2], v1[3]);
                    if (MODE == 2) { const float r0 = bflo(w.x), r1 = bfhi(w.x), r2 = bflo(w.y), r3 = bfhi(w.y), r4 = bflo(w.z), r5 = bfhi(w.z), r6 = bflo(w.w), r7 = bfhi(w.w);
                        ss += ((r0 * r0 + r1 * r1) + (r2 * r2 + r3 * r3)) + ((r4 * r4 + r5 * r5) + (r6 * r6 + r7 * r7)); }
                    *(PG8_LAS u32x4*)(wp + 64 * bj) = w;
                }
                const u32x4 l0 = *(const PG8_LAS u32x4*)rp, l1 = *(const PG8_LAS u32x4*)(rp + 8 * SCR_PITCH);
                bf16_t* gp = base + (size_t)(rowg + rr) * ldc + colw + 8 * ch;
                st16(gp, l0); st16(gp + (size_t)8 * ldc, l1);
                if (MODE == 2) {
                    ss += __shfl_xor(ss, 16); ss += __shfl_xor(ss, 32);
                    if (fq == 0) ssq_out[(size_t)(rowg + fr) * 16 + pn * 4 + wc] = ss;
                }
            }
        }
    }
    __device__ __forceinline__ void operator()(const f32x4 (&acc)[2][2][4][2], const Unit& u, int wr, int wc, int fr, int fq) const {
        const int row0 = u.pm * BM + wr * 64 + fr;
        bf16_t* base = O1; int ldc = ldc1; int colt = u.pn * BM;
        if (u.pn >= split_pn) { base = O2; ldc = ldc2; colt = (u.pn - split_pn) * BM; }
        const int colw = colt + wc * 64;
        float rs[2][4];
        if (ssq_in) {
            const int lane = fr + 16 * fq, rq = lane >> 2, cq = lane & 3;
            f32x4 q[2][4];
#pragma unroll
            for (int ai = 0; ai < 2; ++ai)
#pragma unroll
                for (int m = 0; m < 4; ++m) q[ai][m] = *(const f32x4*)(ssq_in + (size_t)(u.pm * BM + ai * HALF + wr * 64 + m * 16 + rq) * 16 + 4 * cq);
#pragma unroll
            for (int ai = 0; ai < 2; ++ai)
#pragma unroll
                for (int m = 0; m < 4; ++m) { float t = (q[ai][m][0] + q[ai][m][1]) + (q[ai][m][2] + q[ai][m][3]); t += __shfl_xor(t, 1); t += __shfl_xor(t, 2);
                    const float tr = __shfl(t, 4 * fr);
                    const float r = __builtin_amdgcn_rsqf(tr * (1.0f / 1024.0f) + 1e-6f); rs[ai][m] = (mode >= 2) ? r * r : r; }
        } else {
#pragma unroll
            for (int ai = 0; ai < 2; ++ai)
#pragma unroll
                for (int m = 0; m < 4; ++m) rs[ai][m] = 1.0f;
        }
        const int rowt = u.pm * BM;
        if (mode == 1) body<1>(acc, base, ldc, rowt, colw, rs, u.pn, wr, wc, fr, fq);
        else if (mode == 0) body<0>(acc, base, ldc, rowt, colw, rs, u.pn, wr, wc, fr, fq);
        else if (mode == 2) body<2>(acc, base, ldc, rowt, colw, rs, u.pn, wr, wc, fr, fq);
        else body<3>(acc, base, ldc, rowt, colw, rs, u.pn, wr, wc, fr, fq);
    }
};

template <class Epi, class Sched, bool ALIGN_EPI = false, bool SP2 = false>
__device__ __forceinline__ void gemm_phase(PG8_LAS unsigned char* lds, const Gemm g, const Sched& S, const Epi& E) {
    int tid_ = threadIdx.x; asm volatile("" : "+v"(tid_));
    const int tid = tid_, wid = __builtin_amdgcn_readfirstlane(tid >> 6), lane = tid & 63, wr = wid >> 2, wc = wid & 3, fr = lane & 15, fq = lane >> 4;
    const int K = g.K, nt = K / BK;
    unsigned voffA[2], voffB[2];
#pragma unroll
    for (int i = 0; i < 2; ++i) { int R, C; stage_rc(tid * 16 + i * 8192, R, C); const int Rb = Epi::PERM ? (Epi::WIDE ? (64 * (R >> 5) + perm32(R & 31)) : ((R & ~31) + perm32(R & 31))) : R;
        voffA[i] = (unsigned)(R * K + C) * 2u; voffB[i] = (unsigned)(Rb * K + C) * 2u; }
    const size_t kstep = (size_t)(BK * 2);
    const size_t hstep = (size_t)HALF * K * 2;
    const size_t tstep = 2 * hstep;
    const size_t hstepB = (Epi::PERM && Epi::WIDE) ? (size_t)32 * K * 2 : hstep;
    const unsigned ldsw = (unsigned)wid * 1024u;
    const int aoff = lds_byte(wr * 64 + fr, fq * 8), boff = lds_byte(wc * 32 + fr, fq * 8);
#define PG8_SA(b, h) (((b) * 2 + (h)) * HTB)
#define PG8_SB(b, h) ((4 + (b) * 2 + (h)) * HTB)
#define PG8_STAGE(bufoff, gbase, voff) do { _Pragma("unroll") for (int _i = 0; _i < 2; ++_i) \
        __builtin_amdgcn_global_load_lds((const unsigned*)((const char*)(gbase) + (voff)[_i]), (PG8_LAS unsigned*)(lds + (bufoff) + ldsw + _i * 8192), 16, 0, 0); } while (0)
#define PG8_LDA(dst, b, h) do { _Pragma("unroll") for (int m = 0; m < 4; ++m) _Pragma("unroll") for (int k = 0; k < 2; ++k) dst[m][k] = *(const PG8_LAS bf16x8*)(lds + PG8_SA(b, h) + aoff + m * 2048 + k * 1024); } while (0)
#define PG8_LDB(dst, b, h) do { _Pragma("unroll") for (int n = 0; n < 2; ++n) _Pragma("unroll") for (int k = 0; k < 2; ++k) dst[n][k] = *(const PG8_LAS bf16x8*)(lds + PG8_SB(b, h) + boff + n * 2048 + k * 1024); } while (0)
#define PG8_MMA(ai, bj, At, Bt) do { __builtin_amdgcn_s_setprio(1); _Pragma("unroll") for (int m = 0; m < 4; ++m) _Pragma("unroll") for (int n = 0; n < 2; ++n) _Pragma("unroll") for (int k = 0; k < 2; ++k) \
        acc[ai][bj][m][n] = __builtin_amdgcn_mfma_f32_16x16x32_bf16(Bt[n][k], At[m][k], acc[ai][bj][m][n], 0, 0, 0); __builtin_amdgcn_s_setprio(0); } while (0)
#define PG8_WAIT_V(n) asm volatile("s_waitcnt vmcnt(" #n ")" ::: "memory")
#define PG8_WAIT_L(n) asm volatile("s_waitcnt lgkmcnt(" #n ")" ::: "memory")
#define PG8_BAR __builtin_amdgcn_s_barrier()
#define PG8_SCHED __builtin_amdgcn_sched_barrier(0)
    Unit cur, nxt; int ui = 0;
    if (!S.next(0, cur)) return;
    f32x4 acc[2][2][4][2];
#pragma unroll
    for (int a = 0; a < 2; ++a)
#pragma unroll
        for (int b = 0; b < 2; ++b)
#pragma unroll
            for (int m = 0; m < 4; ++m)
#pragma unroll
                for (int n = 0; n < 2; ++n) acc[a][b][m][n] = (f32x4){0.f, 0.f, 0.f, 0.f};
    bf16x8 At[4][2], B0[2][2], B1[2][2];
    const char* cA = (const char*)g.A + (size_t)cur.pm * tstep; const char* cB = (const char*)g.Bt + (size_t)cur.pn * tstep;
    S.a_ready(cur);
    if constexpr (SP2) {
        PG8_STAGE(PG8_SB(0, 0), cB, voffB); PG8_STAGE(PG8_SB(0, 1), cB + hstepB, voffB); PG8_STAGE(PG8_SA(0, 0), cA, voffA); PG8_STAGE(PG8_SA(0, 1), cA + hstep, voffA);
        if (wr == 1) PG8_BAR;
        PG8_WAIT_V(2); PG8_BAR;
        PG8_STAGE(PG8_SB(1, 0), cB + kstep, voffB); PG8_STAGE(PG8_SA(1, 0), cA + kstep, voffA); PG8_STAGE(PG8_SB(1, 1), cB + hstepB + kstep, voffB);
        PG8_WAIT_V(6); PG8_BAR;
    } else {
        PG8_STAGE(PG8_SB(0, 0), cB, voffB); PG8_STAGE(PG8_SA(0, 0), cA, voffA); PG8_STAGE(PG8_SB(0, 1), cB + hstepB, voffB); PG8_STAGE(PG8_SA(0, 1), cA + hstep, voffA);
        if (wr == 1) PG8_BAR;
        PG8_WAIT_V(4); PG8_BAR;
        PG8_STAGE(PG8_SB(1, 0), cB + kstep, voffB); PG8_STAGE(PG8_SA(1, 0), cA + kstep, voffA); PG8_STAGE(PG8_SB(1, 1), cB + hstepB + kstep, voffB);
        PG8_WAIT_V(6); PG8_BAR;
    }
    for (;;) {
        const bool has_next = S.next(ui + 1, nxt);
        const char* nA = has_next ? (const char*)g.A + (size_t)nxt.pm * tstep : cA; const char* nB = has_next ? (const char*)g.Bt + (size_t)nxt.pn * tstep : cB;
        for (int t = 0; t < nt; t += 2) {
            const bool last = (t == nt - 2);
            const char* a1 = cA + (size_t)(t + 1) * kstep;
            const char* a2 = last ? nA : cA + (size_t)(t + 2) * kstep; const char* b2 = last ? nB : cB + (size_t)(t + 2) * kstep;
            const char* a3 = a2 + kstep; const char* b3 = b2 + kstep;
            if (last && has_next) S.a_ready(nxt);
            if constexpr (SP2) {
            PG8_LDB(B0, 0, 0); PG8_LDB(B1, 0, 1); PG8_SCHED; PG8_LDA(At, 0, 0); PG8_STAGE(PG8_SA(1, 1), a1 + hstep, voffA);
            PG8_WAIT_V(8); PG8_WAIT_L(0); PG8_BAR; PG8_MMA(0, 0, At, B0); PG8_MMA(0, 1, At, B1); PG8_BAR; PG8_SCHED;
            PG8_LDA(At, 0, 1); PG8_STAGE(PG8_SB(0, 0), b2, voffB); PG8_STAGE(PG8_SB(0, 1), b2 + hstepB, voffB); PG8_STAGE(PG8_SA(0, 0), a2, voffA);
            PG8_WAIT_V(8); PG8_WAIT_L(0); PG8_BAR; PG8_MMA(1, 0, At, B0); PG8_MMA(1, 1, At, B1); PG8_BAR; PG8_SCHED;
            PG8_LDB(B0, 1, 0); PG8_LDB(B1, 1, 1); PG8_SCHED; PG8_LDA(At, 1, 0); PG8_STAGE(PG8_SA(0, 1), a2 + hstep, voffA);
            PG8_WAIT_V(8); PG8_WAIT_L(0); PG8_BAR; PG8_MMA(0, 0, At, B0); PG8_MMA(0, 1, At, B1); PG8_BAR; PG8_SCHED;
            PG8_LDA(At, 1, 1); PG8_STAGE(PG8_SB(1, 0), b3, voffB); PG8_STAGE(PG8_SB(1, 1), b3 + hstepB, voffB); PG8_STAGE(PG8_SA(1, 0), a3, voffA);
            PG8_WAIT_V(8); PG8_WAIT_L(0); PG8_BAR; PG8_MMA(1, 0, At, B0); PG8_MMA(1, 1, At, B1); PG8_BAR; PG8_SCHED;
            } else {
            PG8_LDB(B0, 0, 0); PG8_SCHED; PG8_LDA(At, 0, 0); PG8_STAGE(PG8_SA(1, 1), a1 + hstep, voffA);
            PG8_WAIT_L(8); PG8_BAR; PG8_WAIT_L(0); PG8_MMA(0, 0, At, B0); PG8_BAR; PG8_SCHED;
            PG8_LDB(B1, 0, 1); PG8_STAGE(PG8_SB(0, 0), b2, voffB);
            PG8_BAR; PG8_WAIT_L(0); PG8_MMA(0, 1, At, B1); PG8_BAR;
            PG8_LDA(At, 0, 1); PG8_STAGE(PG8_SA(0, 0), a2, voffA);
            PG8_BAR; PG8_WAIT_L(0); PG8_MMA(1, 0, At, B0); PG8_BAR; PG8_SCHED;
            PG8_STAGE(PG8_SB(0, 1), b2 + hstepB, voffB);
            PG8_WAIT_V(6); PG8_BAR; PG8_MMA(1, 1, At, B1); PG8_BAR;
            PG8_LDB(B0, 1, 0); PG8_SCHED; PG8_LDA(At, 1, 0); PG8_STAGE(PG8_SA(0, 1), a2 + hstep, voffA);
            PG8_WAIT_L(8); PG8_BAR; PG8_WAIT_L(0); PG8_MMA(0, 0, At, B0); PG8_BAR; PG8_SCHED;
            PG8_LDB(B1, 1, 1); PG8_STAGE(PG8_SB(1, 0), b3, voffB);
            PG8_BAR; PG8_WAIT_L(0); PG8_MMA(0, 1, At, B1); PG8_BAR;
            PG8_LDA(At, 1, 1); PG8_STAGE(PG8_SA(1, 0), a3, voffA);
            PG8_BAR; PG8_WAIT_L(0); PG8_MMA(1, 0, At, B0); PG8_BAR; PG8_SCHED;
            PG8_STAGE(PG8_SB(1, 1), b3 + hstepB, voffB);
            PG8_WAIT_V(6); PG8_BAR; PG8_MMA(1, 1, At, B1); PG8_BAR;
            }
        }
        if constexpr (ALIGN_EPI) { if (wr == 0) PG8_BAR; }
        if constexpr (!Epi::AFTER_DRAIN) { E(acc, cur, wr, wc, fr, fq); S.done(cur); }
        if (!has_next) break;
#pragma unroll
        for (int a = 0; a < 2; ++a)
#pragma unroll
            for (int b = 0; b < 2; ++b)
#pragma unroll
                for (int m = 0; m < 4; ++m)
#pragma unroll
                    for (int n = 0; n < 2; ++n) acc[a][b][m][n] = (f32x4){0.f, 0.f, 0.f, 0.f};
        cur = nxt; cA = nA; cB = nB; ++ui;
        if constexpr (ALIGN_EPI) { if (wr == 1) PG8_BAR; }
    }
    PG8_WAIT_V(0);
    if constexpr (!ALIGN_EPI) { if (wr == 0) PG8_BAR; }
    PG8_BAR;
    if constexpr (Epi::AFTER_DRAIN) { E.fused(acc, cur, wr, wc, fr, fq, lds, wid, lane); S.done(cur); }
#undef PG8_SA
#undef PG8_SB
#undef PG8_STAGE
#undef PG8_LDA
#undef PG8_LDB
#undef PG8_MMA
#undef PG8_WAIT_V
#undef PG8_WAIT_L
#undef PG8_BAR
#undef PG8_SCHED
}
}

constexpr int NWAVES = 8, NTHR = 512;
constexpr int DM = 1024, BATCH = 8, SEQ = 4096, DEPTH = 4, NA = 2;
constexpr int M = BATCH * SEQ;
constexpr int HD = 64, MEMLEN = 256, MAINW = 768, DFF = 4096;
constexpr int MROWS = BATCH * MEMLEN;
constexpr float EPS = 1e-6f;
constexpr float LOG2E = 1.4426950408889634f;

constexpr size_t MiB = 1u << 20;
constexpr size_t WS_WIN = 0;
constexpr size_t WS_WOUT = 12 * MiB;
constexpr size_t WS_WUP = 20 * MiB;
constexpr size_t WS_WDN = 52 * MiB;
constexpr size_t WS_WMKV = 84 * MiB;
constexpr size_t WS_WPOOL = 88 * MiB;
constexpr size_t WS_MEMN = 92 * MiB;
constexpr size_t WS_MKV = 96 * MiB;
constexpr size_t WS_KV = 104 * MiB;
constexpr size_t WS_XN = 136 * MiB;
constexpr size_t WS_BIG = 200 * MiB;
constexpr size_t WS_CTL = 456 * MiB;
constexpr size_t CTL_BYTES = 65536;
constexpr size_t WS_SSQ = 457 * MiB;
constexpr size_t WS_END = 461 * MiB;

constexpr int LDS_BYTES = 155648;
constexpr int EPI_SCR_OFF = 135168;
constexpr int MISC_OFF = 131072;

#define LAS __attribute__((address_space(3)))
typedef unsigned short bf16;
typedef unsigned v4u __attribute__((ext_vector_type(4)));
typedef unsigned v2u __attribute__((ext_vector_type(2)));
typedef float f32x4 __attribute__((ext_vector_type(4)));
typedef float f32x16 __attribute__((ext_vector_type(16)));
typedef short bf16x8 __attribute__((ext_vector_type(8)));
typedef short s16x4 __attribute__((ext_vector_type(4)));
#define LDS_WAIT() asm volatile("s_waitcnt lgkmcnt(0)" ::: "memory")
__device__ __forceinline__ unsigned pk2(float lo, float hi) { return pg8::cvt_pk_bf16(lo, hi); }
__device__ __forceinline__ float bf_lo(unsigned u) { return __uint_as_float(u << 16); }
__device__ __forceinline__ float bf_hi(unsigned u) { return __uint_as_float(u & 0xffff0000u); }
__device__ __forceinline__ void unpack8(const v4u r, float* f) { f[0] = bf_lo(r.x); f[1] = bf_hi(r.x); f[2] = bf_lo(r.y); f[3] = bf_hi(r.y); f[4] = bf_lo(r.z); f[5] = bf_hi(r.z); f[6] = bf_lo(r.w); f[7] = bf_hi(r.w); }
__device__ __forceinline__ v4u pack8(const float* f) { v4u o; o.x = pk2(f[0], f[1]); o.y = pk2(f[2], f[3]); o.z = pk2(f[4], f[5]); o.w = pk2(f[6], f[7]); return o; }
__device__ __forceinline__ float wave_sum(float v) {
#pragma unroll
    for (int o = 1; o < 64; o <<= 1) v += __shfl_xor(v, o);
    return v;
}
#define XB_TMO      128
#define XB_XCNT(j)  (256  + 64 * (j))
#define XB_XSUB(j)  (1280 + 64 * (j))
#define XB_XGEN(j)  (2304 + 64 * (j))
#define XB_TOP      3328
#define XB_TOPGEN   3392
#define XCD_BAR_WORDS 3456
#define XB_SPIN_CAP (1u << 18)

__device__ __forceinline__ unsigned xb_ld(unsigned* p)              { return __hip_atomic_load(p, __ATOMIC_RELAXED, __HIP_MEMORY_SCOPE_AGENT); }
__device__ __forceinline__ unsigned xb_add(unsigned* p, unsigned v) { return __hip_atomic_fetch_add(p, v, __ATOMIC_RELAXED, __HIP_MEMORY_SCOPE_AGENT); }
__device__ __forceinline__ unsigned xb_xcc_id() { return (unsigned)__builtin_amdgcn_s_getreg((3 << 11) | 20) & 0xFu; }
#define XB_SPIN(cond, bar) do { unsigned _sp = 0; while (cond) { __builtin_amdgcn_s_sleep(1); \
    if ((++_sp & 255u) == 0u) { if (xb_ld(&(bar)[XB_TMO])) break; if (_sp > XB_SPIN_CAP) { atomicAdd(&(bar)[XB_TMO], 1u); break; } } } } while (0)

struct XcdBarrier {
    unsigned* bar; unsigned x;
    volatile LAS unsigned* st;
};

__device__ __forceinline__ XcdBarrier xcd_barrier_post(unsigned* bar, volatile LAS unsigned* st) {
    XcdBarrier b; b.bar = bar; b.x = xb_xcc_id(); b.st = st;
    if (threadIdx.x == 0) (void)xb_add(&bar[XB_XCNT(b.x)], 1u);
    return b;
}
__device__ __forceinline__ void xcd_barrier_complete(unsigned* bar, unsigned x, unsigned& nloc, unsigned& nx) {
    const unsigned G = gridDim.x * gridDim.y * gridDim.z;
    unsigned sum, cnt, mine, sp = 0u;
    for (;;) {
        sum = 0u; cnt = 0u; mine = 0u;
#pragma unroll
        for (unsigned j = 0; j < 16; ++j) { const unsigned c = xb_ld(&bar[XB_XCNT(j)]); sum += c; cnt += (c > 0u) ? 1u : 0u; mine = (j == x) ? c : mine; }
        if (sum == G) break;
        __builtin_amdgcn_s_sleep(1);
        if ((++sp & 255u) == 0u) { if (xb_ld(&bar[XB_TMO])) break; if (sp > XB_SPIN_CAP) { atomicAdd(&bar[XB_TMO], 1u); break; } }
    }
    nloc = mine > 0u ? mine : 1u; nx = cnt > 0u ? cnt : 1u;
}

__device__ __forceinline__ void xcd_barrier(const XcdBarrier& b) {
    asm volatile("s_waitcnt vmcnt(0)" ::: "memory");
    __syncthreads();
    if (threadIdx.x == 0) {
        unsigned* bar = b.bar;
        __builtin_amdgcn_s_waitcnt(0);
        unsigned nloc = b.st[0], nx = b.st[1];
        if (nloc == 0u) { xcd_barrier_complete(bar, b.x, nloc, nx); b.st[0] = nloc; b.st[1] = nx; }
        const unsigned old = xb_add(&bar[XB_XSUB(b.x)], 1u);
        const unsigned gen = old / nloc;
        if (old + 1u == (gen + 1u) * nloc) {
            __builtin_amdgcn_fence(__ATOMIC_RELEASE, "agent");
            asm volatile("s_waitcnt vmcnt(0)" ::: "memory");
            const unsigned og = xb_add(&bar[XB_TOP], 1u);
            const unsigned tg = og / nx;
            if (og + 1u == (tg + 1u) * nx) xb_add(&bar[XB_TOPGEN], 1u);
            else XB_SPIN(xb_ld(&bar[XB_TOPGEN]) == tg, bar);
            __builtin_amdgcn_fence(__ATOMIC_ACQUIRE, "agent");
            xb_add(&bar[XB_XGEN(b.x)], 1u);
            asm volatile("s_waitcnt vmcnt(0)" ::: "memory");
        } else {
            XB_SPIN(xb_ld(&bar[XB_XGEN(b.x)]) == gen, bar);
            __builtin_amdgcn_fence(__ATOMIC_ACQUIRE, "agent");
            asm volatile("s_waitcnt vmcnt(0)" ::: "memory");
        }
    }
    __syncthreads();
}

namespace att {
constexpr int KP = 144;
constexpr int OS_PITCH = 144, OS_BYTES = 32 * OS_PITCH;
__device__ __forceinline__ int crow(int r, int hi) { return (r & 3) + 8 * (r >> 2) + 4 * hi; }

struct StageRegs { v4u kr[6], va[3], vb[3]; };
template <int NKEYS>
__device__ __forceinline__ void stage_load(StageRegs& R, const bf16* ksrc, const bf16* vsrc, int pitch, int first_valid, int tid) {
    constexpr int NK = NKEYS * 8 / NTHR, NV = NKEYS * 4 / NTHR;
    const int c = tid & 7, r0 = tid >> 3;
#pragma unroll
    for (int it = 0; it < NK; ++it) { const int row = r0 + it * (NTHR / 8); R.kr[it] = (v4u){0u, 0u, 0u, 0u}; if (row >= first_valid) R.kr[it] = *(const v4u*)(ksrc + (long)row * pitch + 8 * c); }
#pragma unroll
    for (int it = 0; it < NV; ++it) { const int kp = r0 + it * (NTHR / 8); R.va[it] = (v4u){0u, 0u, 0u, 0u}; R.vb[it] = R.va[it];
        if (2 * kp >= first_valid) { R.va[it] = *(const v4u*)(vsrc + (long)(2 * kp) * pitch + 8 * c); R.vb[it] = *(const v4u*)(vsrc + (long)(2 * kp + 1) * pitch + 8 * c); } }
#pragma unroll
    for (int it = NK; it < 6; ++it) R.kr[it] = (v4u){0u, 0u, 0u, 0u};
#pragma unroll
    for (int it = NV; it < 3; ++it) { R.va[it] = (v4u){0u, 0u, 0u, 0u}; R.vb[it] = (v4u){0u, 0u, 0u, 0u}; }
}
template <int NKEYS, int VP>
__device__ __forceinline__ void stage_write(const StageRegs& R, LAS unsigned char* Kl, LAS unsigned char* Vt, const float* gain, int tid) {
    constexpr int NK = NKEYS * 8 / NTHR, NV = NKEYS * 4 / NTHR;
    const int c = tid & 7, r0 = tid >> 3;
    float g[8];
#pragma unroll
    for (int i = 0; i < 8; ++i) g[i] = gain[8 * c + i];
#pragma unroll
    for (int it = 0; it < NK; ++it) {
        const int row = r0 + it * (NTHR / 8);
        float f[8]; unpack8(R.kr[it], f);
        float ss = 0.f;
#pragma unroll
        for (int i = 0; i < 8; ++i) ss += f[i] * f[i];
        ss += __shfl_xor(ss, 1); ss += __shfl_xor(ss, 2); ss += __shfl_xor(ss, 4);
        const float rstd = __builtin_amdgcn_rsqf(ss * (1.0f / 64.0f) + EPS);
#pragma unroll
        for (int i = 0; i < 8; ++i) f[i] = f[i] * rstd * g[i];
        *(LAS v4u*)(Kl + row * KP + 16 * c) = pack8(f);
    }
#pragma unroll
    for (int it = 0; it < NV; ++it) {
        const int kp = r0 + it * (NTHR / 8);
        const v4u a = R.va[it], b = R.vb[it];
        LAS unsigned char* p = Vt + (8 * c) * VP + 4 * kp;
        *(LAS unsigned*)(p + 0 * VP) = (a.x & 0xffffu) | (b.x << 16);
        *(LAS unsigned*)(p + 1 * VP) = (a.x >> 16) | (b.x & 0xffff0000u);
        *(LAS unsigned*)(p + 2 * VP) = (a.y & 0xffffu) | (b.y << 16);
        *(LAS unsigned*)(p + 3 * VP) = (a.y >> 16) | (b.y & 0xffff0000u);
        *(LAS unsigned*)(p + 4 * VP) = (a.z & 0xffffu) | (b.z << 16);
        *(LAS unsigned*)(p + 5 * VP) = (a.z >> 16) | (b.z & 0xffff0000u);
        *(LAS unsigned*)(p + 6 * VP) = (a.w & 0xffffu) | (b.w << 16);
        *(LAS unsigned*)(p + 7 * VP) = (a.w >> 16) | (b.w & 0xffff0000u);
    }
}
struct QRaw { v4u r[4]; };
__device__ __forceinline__ void q_load(QRaw& q, const bf16* Q, int qpitch, int lane) {
    const bf16* qp = Q + (long)(lane & 31) * qpitch + 8 * (lane >> 5);
#pragma unroll
    for (int s = 0; s < 4; ++s) q.r[s] = *(const v4u*)(qp + 16 * s);
}
struct QLine { v4u r[4]; };
__device__ __forceinline__ void q_load_lines(QLine& q, const bf16* Q, int qpitch, int lane) {
    const bf16* qp = Q + (long)(lane >> 3) * qpitch + 8 * (lane & 7);
#pragma unroll
    for (int k = 0; k < 4; ++k) q.r[k] = *(const v4u*)(qp + (long)(8 * k) * qpitch);
}
__device__ __forceinline__ void q_redistribute(const QLine& ql, QRaw& q, LAS unsigned char* stage, int lane) {
#pragma unroll
    for (int k = 0; k < 4; ++k) *(LAS v4u*)(stage + (8 * k + (lane >> 3)) * OS_PITCH + 16 * (lane & 7)) = ql.r[k];
#pragma unroll
    for (int s = 0; s < 4; ++s) q.r[s] = *(const LAS v4u*)(stage + (lane & 31) * OS_PITCH + (2 * s + (lane >> 5)) * 16);
}
__device__ __forceinline__ void q_gains(const float* gq, int lane, f32x4 (&gv)[8]) {
#pragma unroll
    for (int s = 0; s < 4; ++s) { gv[2 * s] = *(const f32x4*)(gq + 16 * s + 8 * (lane >> 5)); gv[2 * s + 1] = *(const f32x4*)(gq + 16 * s + 8 * (lane >> 5) + 4); }
}
__device__ __forceinline__ void q_norm(const QRaw& q, const f32x4 (&gv)[8], int lane, bf16x8 (&qf)[4]) {
    float f[4][8]; float ss = 0.f;
#pragma unroll
    for (int s = 0; s < 4; ++s) { unpack8(q.r[s], f[s]);
#pragma unroll
        for (int j = 0; j < 8; ++j) ss += f[s][j] * f[s][j]; }
    ss += __shfl_xor(ss, 32);
    const float rstd = (0.125f * LOG2E) * __builtin_amdgcn_rsqf(ss * (1.0f / 64.0f) + EPS);
#pragma unroll
    for (int s = 0; s < 4; ++s) {
#pragma unroll
        for (int j = 0; j < 8; ++j) f[s][j] = f[s][j] * rstd * gv[2 * s + (j >> 2)][j & 3];
        qf[s] = __builtin_bit_cast(bf16x8, pack8(f[s]));
    }
}
__device__ __forceinline__ float score_bound2(const float* gq, const float* gk, int lane) {
    float a = fabsf(gq[lane]), b = fabsf(gk[lane]);
#pragma unroll
    for (int o = 1; o < 64; o <<= 1) { a = fmaxf(a, __shfl_xor(a, o)); b = fmaxf(b, __shfl_xor(b, o)); }
    return 8.1f * a * b * LOG2E;
}
template <int NKT, bool SWA, int VP, int NH>
__device__ __forceinline__ void task(LAS const unsigned char* Kl, LAS const unsigned char* Vt, const bf16x8 (&qf)[NH][4],
                                     bf16* const (&O)[NH], int opitch, const float (&slope2)[NH], const float (&sink2)[NH], const float (&shift2)[NH], int kt_first, int lane, LAS unsigned char* oscr) {
    const int ql = lane & 31, hi = lane >> 5;
    int qh = ql - 4 * hi; asm volatile("" : "+v"(qh));
    float base[NH];
#pragma unroll
    for (int h = 0; h < NH; ++h) { base[h] = -shift2[h]; if (SWA) base[h] -= slope2[h] * (float)(qh + 128); }
    const short one = (ql == 0) ? (short)0x3F80 : (short)0;
    const bf16x8 onesf = (bf16x8){one, one, one, one, one, one, one, one};
    constexpr bool ONES = (NH == 1);
    f32x16 Oa[NH][ONES ? 3 : 2]; float vsum[NH];
#pragma unroll
    for (int h = 0; h < NH; ++h) { vsum[h] = 0.f; Oa[h][0] = (f32x16){0.f, 0.f, 0.f, 0.f, 0.f, 0.f, 0.f, 0.f, 0.f, 0.f, 0.f, 0.f, 0.f, 0.f, 0.f, 0.f}; Oa[h][1] = Oa[h][0]; if (ONES) Oa[h][ONES ? 2 : 0] = Oa[h][0]; }
#pragma unroll
    for (int kt = 0; kt < NKT; ++kt) {
        if (SWA && kt < kt_first) continue;
        f32x16 S[NH];
#pragma unroll
        for (int h = 0; h < NH; ++h)
#pragma unroll
            for (int r = 0; r < 16; ++r) {
                const int cr = (r & 3) + 8 * (r >> 2);
                float c = base[h];
                if (SWA) {
                    c = fmaf(slope2[h], (float)(32 * kt + cr), base[h]);
                    if (kt == 0) c = (cr > qh) ? c : -1e30f;
                    if (kt == NKT - 1) c = (cr <= qh) ? c : -1e30f;
                }
                S[h][r] = c;
            }
#pragma unroll
        for (int s = 0; s < 4; ++s) {
            const bf16x8 kf = *(LAS const bf16x8*)(Kl + (32 * kt + ql) * KP + (16 * s + 8 * hi) * 2);
#pragma unroll
            for (int h = 0; h < NH; ++h) S[h] = __builtin_amdgcn_mfma_f32_32x32x16_bf16(kf, qf[h][s], S[h], 0, 0, 0);
        }
#pragma unroll
        for (int h = 0; h < NH; ++h)
#pragma unroll
            for (int r = 0; r < 16; ++r) { S[h][r] = __builtin_amdgcn_exp2f(S[h][r]); if (!ONES) vsum[h] += S[h][r]; }
#pragma unroll
        for (int s = 0; s < 2; ++s) {
            bf16x8 pf[NH];
#pragma unroll
            for (int h = 0; h < NH; ++h) { v4u pw; pw.x = pk2(S[h][8 * s + 0], S[h][8 * s + 1]); pw.y = pk2(S[h][8 * s + 2], S[h][8 * s + 3]);
                pw.z = pk2(S[h][8 * s + 4], S[h][8 * s + 5]); pw.w = pk2(S[h][8 * s + 6], S[h][8 * s + 7]); pf[h] = __builtin_bit_cast(bf16x8, pw); }
#pragma unroll
            for (int dt = 0; dt < 2; ++dt) {
                LAS const unsigned char* vp = Vt + (32 * dt + ql) * VP + (32 * kt + 16 * s + 4 * hi) * 2;
                const s16x4 lo = *(LAS const s16x4*)vp; const s16x4 h4 = *(LAS const s16x4*)(vp + 16);
                const bf16x8 vf = (bf16x8){lo[0], lo[1], lo[2], lo[3], h4[0], h4[1], h4[2], h4[3]};
#pragma unroll
                for (int h = 0; h < NH; ++h) Oa[h][dt] = __builtin_amdgcn_mfma_f32_32x32x16_bf16(vf, pf[h], Oa[h][dt], 0, 0, 0);
            }
            if (ONES)
#pragma unroll
                for (int h = 0; h < NH; ++h) Oa[h][ONES ? 2 : 0] = __builtin_amdgcn_mfma_f32_32x32x16_bf16(onesf, pf[h], Oa[h][ONES ? 2 : 0], 0, 0, 0);
        }
        __builtin_amdgcn_sched_barrier(0);
    }
#pragma unroll
    for (int h = 0; h < NH; ++h) {
        float sum = ONES ? Oa[h][ONES ? 2 : 0][0] : vsum[h]; sum += __shfl_xor(sum, 32);
        if (SWA) sum += __builtin_amdgcn_exp2f(sink2[h] - shift2[h]);
        const float inv = 1.0f / sum;
        LAS unsigned char* so = oscr + ql * OS_PITCH + 8 * hi;
#pragma unroll
        for (int dt = 0; dt < 2; ++dt)
#pragma unroll
            for (int rg = 0; rg < 4; ++rg) {
                v2u w; w.x = pk2(Oa[h][dt][4 * rg + 0] * inv, Oa[h][dt][4 * rg + 1] * inv); w.y = pk2(Oa[h][dt][4 * rg + 2] * inv, Oa[h][dt][4 * rg + 3] * inv);
                *(LAS v2u*)(so + 64 * dt + 16 * rg) = w;
            }
        const int rr = lane >> 3, ch = lane & 7;
#pragma unroll
        for (int k = 0; k < 4; ++k) {
            const v4u l = *(const LAS v4u*)(oscr + (8 * k + rr) * OS_PITCH + 16 * ch);
            *(v4u*)(O[h] + (long)(8 * k + rr) * opitch + 8 * ch) = l;
        }
    }
}
constexpr int SWA_VP = 776, MEM_VP = 520;
__device__ __forceinline__ LAS unsigned char* out_stage(LAS unsigned char* lds, int wave) { return lds + ((wave < 5) ? (104960 + wave * OS_BYTES) : (131328 + (wave - 5) * OS_BYTES)); }
constexpr int SWA_VT_OFF = 384 * KP, MEM_VT_OFF = 256 * KP;
}

struct Args { const float* in[19]; float* out; unsigned char* ws; int ph_lo, ph_hi; };
typedef const __attribute__((address_space(4))) Args* KArgs;
#define AIN(i) ((const float*)(const __attribute__((address_space(1))) float*)(ap->in[i]))

struct MixP { const bf16* PROJ; const bf16* KV; const bf16* MKV; bf16* CAT; const float *knorm, *qnorm, *sinks, *mknorm, *mqnorm; int l; };
__device__ __forceinline__ void unit_load(const MixP& P, int v, int tid, int wave, att::StageRegs& R) {
    asm volatile("" : "+v"(tid));
    const int lane = tid & 63;
    if (v < 512) {
        const int b = v >> 6, rem = v & 63, kvh = rem >> 4, tb = rem & 15; const long t0 = (long)b * SEQ + tb * 256;
        att::stage_load<384>(R, P.KV + (t0 - 128) * 512 + kvh * 64, P.KV + (t0 - 128) * 512 + 256 + kvh * 64, 512, (tb == 0) ? 128 : 0, tid);
    } else {
        const int u = v - 512, b = u >> 5, rem = u & 31, h = rem >> 3, tb = rem & 7; const long t0 = (long)b * SEQ + tb * 512;
        const bf16* ksrc = P.MKV + (long)(b * MEMLEN) * 2048 + P.l * 512 + h * 64;
        att::stage_load<256>(R, ksrc, ksrc + 256, 2048, 0, tid);
    }
}
__device__ __forceinline__ void unit_write(const MixP& P, int v, LAS unsigned char* lds, int tid, const att::StageRegs& R) {
    asm volatile("" : "+v"(tid));
    if (v < 512) att::stage_write<384, att::SWA_VP>(R, lds, lds + att::SWA_VT_OFF, P.knorm, tid);
    else att::stage_write<256, att::MEM_VP>(R, lds, lds + att::MEM_VT_OFF, P.mknorm + P.l * 64, tid);
}
__device__ __forceinline__ void unit_tasks(const MixP& P, int v, LAS unsigned char* lds, int tid, int wave) {
    asm volatile("" : "+v"(tid));
    const int lane = tid & 63;
    if (v < 512) {
        const int j = P.l - NA;
        const int b = v >> 6, rem = v & 63, kvh = rem >> 4, tb = rem & 15; const long t0 = (long)b * SEQ + tb * 256;
        const int i = wave;
        att::QLine qcur; att::q_load_lines(qcur, P.PROJ + (t0 + 32 * i) * 1024 + (kvh * 3) * 64, 1024, lane);
        LAS unsigned char* const stage = att::out_stage(lds, wave);
        f32x4 gv[8]; att::q_gains(P.qnorm + j * 64, lane, gv);
        float sk3[3];
#pragma unroll
        for (int g = 0; g < 3; ++g) sk3[g] = P.sinks[j * 12 + kvh * 3 + g];
        const float bound2 = att::score_bound2(P.qnorm + j * 64, P.knorm, lane);
        LAS unsigned char* Kl = lds; LAS unsigned char* Vt = lds + att::SWA_VT_OFF;
        const int kt_first = (tb == 0) ? ((4 - i) > 0 ? (4 - i) : 0) : 0;
#pragma unroll 1
        for (int g = 0; g < 3; ++g) {
            const int hq = kvh * 3 + g;
            int ln = lane; asm volatile("" : "+v"(ln));
            att::QLine qn = qcur;
            if (g < 2) att::q_load_lines(qn, P.PROJ + (t0 + 32 * i) * 1024 + (hq + 1) * 64, 1024, ln);
            att::QRaw qr; att::q_redistribute(qcur, qr, stage, ln);
            bf16x8 qf[1][4]; att::q_norm(qr, gv, ln, qf[0]);
            const float slope2 = exp2f(-8.0f * (float)(hq + 1) / 12.0f) * LOG2E;
            const float sink2 = ((g == 0) ? sk3[0] : (g == 1) ? sk3[1] : sk3[2]) * LOG2E;
            const float shift2 = fmaxf(bound2, sink2);
            bf16* const O1[1] = {P.CAT + (t0 + 32 * i) * 1024 + hq * 64}; const float sl1[1] = {slope2}, sk1[1] = {sink2}, sh1[1] = {shift2};
            att::task<5, true, att::SWA_VP, 1>(Kl + 32 * i * att::KP, Vt + 32 * i * 2, qf, O1, 1024, sl1, sk1, sh1, kt_first, ln, stage);
            qcur = qn;
        }
    } else {
        const int u = v - 512, b = u >> 5, rem = u & 31, h = rem >> 3, tb = rem & 7; const long t0 = (long)b * SEQ + tb * 512;
        att::QLine ql0, ql1;
        att::q_load_lines(ql0, P.PROJ + (t0 + 32 * wave) * 1024 + MAINW + h * 64, 1024, lane);
        att::q_load_lines(ql1, P.PROJ + (t0 + 32 * (wave + 8)) * 1024 + MAINW + h * 64, 1024, lane);
        LAS unsigned char* const stage = att::out_stage(lds, wave);
        f32x4 gv[8]; att::q_gains(P.mqnorm + P.l * 64, lane, gv);
        const float bound2 = att::score_bound2(P.mqnorm + P.l * 64, P.mknorm + P.l * 64, lane);
        LAS unsigned char* Kl = lds; LAS unsigned char* Vt = lds + att::MEM_VT_OFF;
        int ln = lane; asm volatile("" : "+v"(ln));
        att::QRaw q0, q1; att::q_redistribute(ql0, q0, stage, ln); att::q_redistribute(ql1, q1, stage, ln);
        bf16x8 qf[2][4]; att::q_norm(q0, gv, ln, qf[0]); att::q_norm(q1, gv, ln, qf[1]);
        bf16* const cat = P.CAT + (t0 + 32 * wave) * 1024 + MAINW + h * 64;
        bf16* const O2[2] = {cat, cat + (long)256 * 1024};
        const float z2[2] = {0.f, 0.f}, sh2[2] = {bound2, bound2};
        att::task<8, false, att::MEM_VP, 2>(Kl, Vt, qf, O2, 1024, z2, z2, sh2, 0, ln, stage);
    }
}
template <int W>
__device__ __forceinline__ void pool_run(const bf16* up, bf16* dp, int tin) {
    constexpr int RUN = 32;
    v4u ring[W]; float s[8];
#pragma unroll
    for (int i = 0; i < 8; ++i) s[i] = 0.f;
#pragma unroll
    for (int k = 0; k < W; ++k) { ring[k] = (v4u){0u, 0u, 0u, 0u}; if (tin > 0) ring[k] = *(const v4u*)(up - (long)(W - k) * 1024); }
#pragma unroll
    for (int k = 0; k < W; ++k) { float f[8]; unpack8(ring[k], f);
#pragma unroll
        for (int i = 0; i < 8; ++i) s[i] += f[i]; }
#pragma unroll
    for (int tb = 0; tb < RUN; tb += 8) {
        v4u xr[8];
#pragma unroll
        for (int j = 0; j < 8; ++j) xr[j] = *(const v4u*)(up + (long)(tb + j) * 1024);
#pragma unroll
        for (int j = 0; j < 8; ++j) {
            const int t = tb + j;
            float x[8], p[8]; unpack8(xr[j], x); unpack8(ring[t % W], p);
            ring[t % W] = xr[j];
            const float rc = (tin > 0 || t + 1 >= W) ? (1.0f / (float)W) : (1.0f / (float)(t + 1));
            float d[8];
#pragma unroll
            for (int i = 0; i < 8; ++i) { s[i] += x[i] - p[i]; d[i] = s[i] * rc - x[i]; }
            *(v4u*)(dp + (long)t * 1024) = pack8(d);
        }
        asm volatile("" ::: "memory");
    }
}
__device__ __forceinline__ void pool_pass(const bf16* PROJ, bf16* DOUT, int bx, int G, int wave, int lane) {
    if (wave >= 6) return;
    for (int wi = bx * 6 + wave; wi < 4 * 3 * 128; wi += G * 6) {
        const int g = wi / 384, rem = wi - g * 384, cb = rem >> 7, rb = rem & 127;
        const int run = rb * 8 + (lane >> 3), c = g * 24 + cb * 8 + (lane & 7);
        const long t0 = (long)run * 32; const int tin = (int)(t0 & (SEQ - 1));
        const bf16* up = PROJ + t0 * 1024 + 8 * c; bf16* dp = DOUT + t0 * 1024 + 8 * c;
        if (g == 0) pool_run<2>(up, dp, tin); else if (g == 1) pool_run<4>(up, dp, tin); else if (g == 2) pool_run<8>(up, dp, tin); else pool_run<16>(up, dp, tin);
    }
}

enum { I_X = 0, I_MEM, I_NORM_MIX, I_W_IN, I_POOL_W, I_POOL_SCALE, I_KV_NORM, I_W_KV, I_K_NORM, I_Q_NORM, I_SINKS, I_MEM_NORM, I_W_MEM_KV,
       I_MEM_Q_NORM, I_MEM_K_NORM, I_W_OUT, I_NORM_MLP, I_W_UP, I_W_DOWN };

constexpr int NTR = 2048 + 2048 + 8192 + 8192 + 1024 + 256;
constexpr size_t WS_TMPA = WS_BIG + 128 * MiB, WS_PP = WS_BIG + 136 * MiB;
struct TrD { const float* W; bf16* WT; const float* gk; int ldw, ldt; };
__device__ __forceinline__ void tr_load(const TrD& d, f32x4 (&v)[8], int lane) {
#pragma unroll
    for (int i = 0; i < 8; ++i) v[i] = *(const f32x4*)(d.W + (size_t)(8 * i + (lane >> 3)) * d.ldw + 4 * (lane & 7));
}
__device__ __forceinline__ void tr_store(const TrD& d, const f32x4 (&v)[8], LAS float* scr, int lane) {
#pragma unroll
    for (int i = 0; i < 8; ++i) { LAS float* p = scr + (8 * i + (lane >> 3)) * 33 + 4 * (lane & 7); p[0] = v[i][0]; p[1] = v[i][1]; p[2] = v[i][2]; p[3] = v[i][3]; }
    LDS_WAIT(); asm volatile("" ::: "memory");
    const int c = lane & 7;
    f32x4 g0 = (f32x4){1.f, 1.f, 1.f, 1.f}, g1 = g0;
    if (d.gk) { g0 = *(const f32x4*)(d.gk + 8 * c); g1 = *(const f32x4*)(d.gk + 8 * c + 4); }
#pragma unroll
    for (int j = 0; j < 4; ++j) { const int n = (lane >> 3) + 8 * j; const LAS float* s = scr + (8 * c) * 33 + n;
        v4u o; o.x = pk2(s[0 * 33] * g0[0], s[1 * 33] * g0[1]); o.y = pk2(s[2 * 33] * g0[2], s[3 * 33] * g0[3]); o.z = pk2(s[4 * 33] * g1[0], s[5 * 33] * g1[1]); o.w = pk2(s[6 * 33] * g1[2], s[7 * 33] * g1[3]);
        *(v4u*)(d.WT + (size_t)n * d.ldt + 8 * c) = o; }
    LDS_WAIT(); asm volatile("" ::: "memory");
}
__device__ __forceinline__ void rms_row(const float* xrow, bf16* orow, int lane) {
    const f32x4* xr = (const f32x4*)xrow + lane;
    f32x4 v[4]; float s = 0.f;
#pragma unroll
    for (int j = 0; j < 4; ++j) { v[j] = xr[64 * j]; s += (v[j].x * v[j].x + v[j].y * v[j].y) + (v[j].z * v[j].z + v[j].w * v[j].w); }
    const float rstd = 1.0f / sqrtf(wave_sum(s) * (1.0f / DM) + EPS);
    unsigned long long* o8 = (unsigned long long*)orow + lane;
#pragma unroll
    for (int j = 0; j < 4; ++j) o8[64 * j] = (unsigned long long)pk2(v[j].x * rstd, v[j].y * rstd) | ((unsigned long long)pk2(v[j].z * rstd, v[j].w * rstd) << 32);
}
struct XRows { f32x4 v[2][4]; };
__device__ __forceinline__ void xrows_load(XRows& x, const float* x0, const float* x1, int lane) {
    const f32x4* pa = (const f32x4*)x0 + 2 * lane; const f32x4* pb = (const f32x4*)x1 + 2 * lane;
#pragma unroll
    for (int j = 0; j < 2; ++j) { x.v[0][2 * j] = pa[128 * j]; x.v[0][2 * j + 1] = pa[128 * j + 1]; x.v[1][2 * j] = pb[128 * j]; x.v[1][2 * j + 1] = pb[128 * j + 1]; }
}
__device__ __forceinline__ void xrows_store(const XRows& x, bf16* o0, bf16* o1, float* q0, float* q1, int lane) {
    float ss[2];
#pragma unroll
    for (int r = 0; r < 2; ++r) {
        v4u* op = (v4u*)(r == 0 ? o0 : o1) + lane; float s = 0.f;
#pragma unroll
        for (int j = 0; j < 2; ++j) {
            const f32x4 a = x.v[r][2 * j], b = x.v[r][2 * j + 1];
            v4u w; w.x = pk2(a.x, a.y); w.y = pk2(a.z, a.w); w.z = pk2(b.x, b.y); w.w = pk2(b.z, b.w);
            const float r0 = bf_lo(w.x), r1 = bf_hi(w.x), r2 = bf_lo(w.y), r3 = bf_hi(w.y), r4 = bf_lo(w.z), r5 = bf_hi(w.z), r6 = bf_lo(w.w), r7 = bf_hi(w.w);
            s += ((r0 * r0 + r1 * r1) + (r2 * r2 + r3 * r3)) + ((r4 * r4 + r5 * r5) + (r6 * r6 + r7 * r7));
            op[64 * j] = w;
        }
        ss[r] = wave_sum(s);
    }
    if (lane < 16) { q0[lane] = (lane == 0) ? ss[0] : 0.f; q1[lane] = (lane == 0) ? ss[1] : 0.f; }
}
__device__ __forceinline__ void fold_item(const float* P, const float* scale, const float* Wo, bf16* WT, int item, int lane) {
    const int c0 = (item >> 4) * 8, n = (item & 15) * 64 + lane;
    float acc[8];
#pragma unroll
    for (int j = 0; j < 8; ++j) acc[j] = 0.f;
    for (int d = 0; d < 192; d += 4) {
        const f32x4 sc = *(const f32x4*)(scale + d);
        float w[4];
#pragma unroll
        for (int e = 0; e < 4; ++e) w[e] = Wo[(size_t)(d + e) * DM + n] * sc[e];
#pragma unroll
        for (int j = 0; j < 8; ++j) { const f32x4 p = *(const f32x4*)(P + (c0 + j) * 192 + d); acc[j] += (p[0] * w[0] + p[1] * w[1]) + (p[2] * w[2] + p[3] * w[3]); }
    }
    *(v4u*)(WT + (size_t)n * DM + c0) = pack8(acc);
}

__device__ __forceinline__ void tr_decode(KArgs ap, unsigned char* ws, int r, TrD& d) {
    const float* W; bf16* WT; const float* gk = nullptr; int ldw, ldt, nblk, item;
    if (r < 2048) { const int l = r >> 9; item = r & 511; W = AIN(I_W_IN) + (size_t)l * DM * DM; ldw = DM; WT = (bf16*)(ws + WS_WIN + l * 3 * MiB); ldt = DM; nblk = 32; gk = AIN(I_NORM_MIX) + l * DM; }
    else if ((r -= 2048) < 2048) { const int l = r >> 9; item = r & 511;
        W = AIN(I_W_OUT) + (size_t)l * DM * DM; ldw = DM; WT = (bf16*)(ws + WS_WOUT + l * 2 * MiB); ldt = DM; nblk = 32;
        if (l < NA && item < 12 * 32) { WT = (bf16*)(ws + WS_TMPA + l * 2 * MiB); ldt = MAINW; } }
    else if ((r -= 2048) < 8192) { const int l = r >> 11; item = r & 2047; W = AIN(I_W_UP) + (size_t)l * DM * DFF; ldw = DFF; WT = (bf16*)(ws + WS_WUP + l * 8 * MiB); ldt = DM; nblk = 128; gk = AIN(I_NORM_MLP) + l * DM; }
    else if ((r -= 8192) < 8192) { const int l = r >> 11; item = r & 2047; W = AIN(I_W_DOWN) + (size_t)l * DFF * DM; ldw = DM; WT = (bf16*)(ws + WS_WDN + l * 8 * MiB); ldt = DFF; nblk = 32; }
    else if ((r -= 8192) < 1024) { const int l = r >> 8; item = r & 255; W = AIN(I_W_MEM_KV) + (size_t)l * DM * 512; ldw = 512; WT = (bf16*)(ws + WS_WMKV) + (size_t)l * 512 * DM; ldt = DM; nblk = 16; gk = AIN(I_MEM_NORM) + l * DM; }
    else { r -= 1024; item = r; W = AIN(I_W_KV); ldw = 512; WT = (bf16*)(ws + WS_WIN + 2 * 3 * MiB) + (size_t)1024 * DM; ldt = DM; nblk = 16; gk = AIN(I_KV_NORM); }
    const int kb = item / nblk, nb = item - kb * nblk, k0 = 64 * kb, n0 = 32 * nb;
    d.W = W + (size_t)k0 * ldw + n0; d.WT = WT + (size_t)n0 * ldt + k0; d.gk = gk ? gk + k0 : nullptr; d.ldw = ldw; d.ldt = ldt;
}
__device__ __forceinline__ void prologue(KArgs ap, unsigned char* ws, LAS unsigned char* lds, int gw, int NGW, int lane, int wave) {
    LAS float* scr = (LAS float*)(lds + wave * 16384);
    {
        int it = gw; TrD dc; f32x4 vc[8];
        bool hc = it < NTR;
        if (hc) { tr_decode(ap, ws, it, dc); tr_load(dc, vc, lane); }
        while (hc) {
            const int itn = it + NGW; const bool hn = itn < NTR;
            TrD dn = dc; f32x4 vn[8];
#pragma unroll
            for (int i = 0; i < 8; ++i) vn[i] = vc[i];
            if (hn) { tr_decode(ap, ws, itn, dn); tr_load(dn, vn, lane); }
            tr_store(dc, vc, scr, lane);
            dc = dn;
#pragma unroll
            for (int i = 0; i < 8; ++i) vc[i] = vn[i];
            hc = hn; it = itn;
        }
    }
    for (int it = gw * 64 + lane; it < 2 * MAINW * (MAINW / 8); it += NGW * 64) {
        const int l = it / (MAINW * (MAINW / 8)), r = it - l * (MAINW * (MAINW / 8)), c = r / (MAINW / 8), ch = r - c * (MAINW / 8), g = c / 192;
        v4u o = (v4u){0u, 0u, 0u, 0u};
        if (ch / 24 == g) { const float* p = AIN(I_POOL_W) + ((size_t)(l * 4 + g) * 192 + (c - g * 192)) * 192 + (8 * ch - g * 192); const float* sc = AIN(I_POOL_SCALE) + l * MAINW + 8 * ch;
            const f32x4 p0 = *(const f32x4*)p, p1 = *(const f32x4*)(p + 4), s0 = *(const f32x4*)sc, s1 = *(const f32x4*)(sc + 4);
            o.x = pk2(p0[0] * s0[0], p0[1] * s0[1]); o.y = pk2(p0[2] * s0[2], p0[3] * s0[3]); o.z = pk2(p1[0] * s1[0], p1[1] * s1[1]); o.w = pk2(p1[2] * s1[2], p1[3] * s1[3]); }
        *(v4u*)((bf16*)(ws + WS_PP + l * 2 * MiB) + (size_t)c * MAINW + 8 * ch) = o;
    }
    for (int m = gw; m < MROWS; m += NGW) rms_row(AIN(I_MEM) + (size_t)m * DM, (bf16*)(ws + WS_MEMN) + (size_t)m * DM, lane);
    {
        int m = gw; XRows xc;
        if (m < M) xrows_load(xc, AIN(I_X) + (size_t)m * DM, AIN(I_X) + (size_t)(m + NGW) * DM, lane);
        while (m < M) {
            const int mn = m + 2 * NGW; XRows xn = xc;
            if (mn < M) xrows_load(xn, AIN(I_X) + (size_t)mn * DM, AIN(I_X) + (size_t)(mn + NGW) * DM, lane);
            xrows_store(xc, (bf16*)(ws + WS_XN) + (size_t)m * DM, (bf16*)(ws + WS_XN) + (size_t)(m + NGW) * DM,
                        (float*)(ws + WS_SSQ + 2 * MiB) + (size_t)m * 16, (float*)(ws + WS_SSQ + 2 * MiB) + (size_t)(m + NGW) * 16, lane);
            xc = xn; m = mn;
        }
    }
}

enum { K_PRO = 0, K_INPROJ, K_MIX, K_OUT, K_UP, K_DOWN };
constexpr int NPHASES = 21;
__device__ __forceinline__ void decode_phase(int ph, int& kind, int& l) {
    if (ph == 0) { kind = K_PRO; l = 0; return; }
    const int p = ph - 1; l = p / 5; const int k = p - 5 * l;
    kind = (k == 0) ? K_INPROJ : (k == 1) ? K_MIX : (k == 2) ? K_OUT : (k == 3) ? K_UP : K_DOWN;
}

__global__ void __launch_bounds__(NTHR, 2) fwd_kernel(Args a) {
    extern __shared__ __attribute__((aligned(16))) unsigned char lds_raw[];
    LAS unsigned char* lds = (LAS unsigned char*)lds_raw;
    volatile LAS unsigned* MISC = (volatile LAS unsigned*)(lds + MISC_OFF);
    if (threadIdx.x < 64) MISC[threadIdx.x] = 0u;
    __syncthreads();
    const int lo = a.ph_lo, hi = a.ph_hi;
    XcdBarrier bar; bar.bar = (unsigned*)(a.ws + WS_CTL); bar.x = 0; bar.st = nullptr;
    if (hi - lo > 1) bar = xcd_barrier_post((unsigned*)(a.ws + WS_CTL), MISC + 8);
    if (lo < 0) { cg::this_grid().sync(); }

    for (int ph = lo; ph < hi; ++ph) {
        int tid = threadIdx.x, bx = blockIdx.x, G = gridDim.x; unsigned long long zo = 0;
        asm volatile("" : "+v"(tid)); asm volatile("" : "+s"(bx), "+s"(G)); asm volatile("" : "+s"(zo));
        unsigned char* ws = a.ws + zo; float* outp = (float*)((unsigned char*)a.out + zo);
        KArgs ap = (KArgs)__builtin_amdgcn_kernarg_segment_ptr(); asm volatile("" : "+s"(ap));
        const int lane = tid & 63, wave = __builtin_amdgcn_readfirstlane(tid >> 6);
        const int gw = bx * NWAVES + wave, NGW = G * NWAVES, gthread = bx * NTHR + tid, nthreads = G * NTHR;
        bf16* const XN = (bf16*)(ws + WS_XN);
        bf16* const PROJ = (bf16*)(ws + WS_BIG);
        bf16* const CAT = (bf16*)(ws + WS_BIG + 64 * MiB);
        bf16* const HID = (bf16*)(ws + WS_BIG);
        bf16* const KV = (bf16*)(ws + WS_KV);
        bf16* const MKV = (bf16*)(ws + WS_MKV);
        int kind, l; decode_phase(ph, kind, l);
        float* const SSQ0 = (float*)(ws + WS_SSQ);
        float* const SSQ1 = (float*)(ws + WS_SSQ + 2 * MiB);
        if (kind == K_PRO) {
            prologue(ap, ws, lds, gw, NGW, lane, wave);
        } else if (kind == K_MIX) {
            MixP P; P.PROJ = PROJ; P.KV = KV; P.MKV = MKV; P.CAT = CAT; P.knorm = AIN(I_K_NORM); P.qnorm = AIN(I_Q_NORM); P.sinks = AIN(I_SINKS);
            P.mknorm = AIN(I_MEM_K_NORM); P.mqnorm = AIN(I_MEM_Q_NORM); P.l = l;
            att::StageRegs R;
            int v = (l < NA) ? 512 + bx : bx;
            if (l < NA) pool_pass(PROJ, CAT, bx, G, wave, lane);
            unit_load(P, v, tid, wave, R);
            while (v < 768) {
                unit_write(P, v, lds, tid, R);
                LDS_WAIT(); __syncthreads();
                const int vn = v + G;
                if (v < 512) { if (vn < 768) unit_load(P, vn, tid, wave, R); unit_tasks(P, v, lds, tid, wave); }
                else { unit_tasks(P, v, lds, tid, wave); if (vn < 768) unit_load(P, vn, tid, wave, R); }
                __syncthreads();
                v = vn;
            }
        } else {
            const int ng = (kind == K_INPROJ && l == 0) ? 4 : 1;
            for (int gi = 0; gi < ng; ++gi) {
                pg8::Gemm g; pg8::EpiB E; E.O2 = KV; E.ldc2 = 512; E.split_pn = 1 << 30; E.mode = 0; E.ssq_in = nullptr; E.ssq_out = SSQ0; E.outf = outp; E.scr = lds + EPI_SCR_OFF; g.M = M; g.K = DM;
                int cb = bx;
                if (kind == K_INPROJ && ng == 4 && gi == 0) { g.A = (const bf16*)(ws + WS_MEMN); g.Bt = (const bf16*)(ws + WS_WMKV); g.M = MROWS; g.N = 2048; E.O1 = MKV; E.ldc1 = 2048; }
                else if (kind == K_INPROJ && ng == 4 && gi < 3) {
                    const int fl = gi - 1; g.A = (const bf16*)(ws + WS_TMPA + fl * 2 * MiB); g.Bt = (const bf16*)(ws + WS_PP + fl * 2 * MiB); g.M = DM; g.N = MAINW; g.K = MAINW;
                    E.O1 = (bf16*)(ws + WS_WOUT + fl * 2 * MiB); E.ldc1 = DM; cb = (bx + G - 64 - 12 * fl) % G; }
                else if (kind == K_INPROJ) { g.A = XN; g.Bt = (const bf16*)(ws + WS_WIN + l * 3 * MiB); g.N = (l == 2) ? 1536 : 1024; E.O1 = PROJ; E.ldc1 = 1024; E.split_pn = 4; E.ssq_in = SSQ1; }
                else if (kind == K_OUT) { g.A = CAT; g.Bt = (const bf16*)(ws + WS_WOUT + l * 2 * MiB); g.N = DM; E.O1 = XN; E.ldc1 = DM; E.mode = 2; }
                else if (kind == K_UP) { g.A = XN; g.Bt = (const bf16*)(ws + WS_WUP + l * 8 * MiB); g.N = DFF; E.O1 = HID; E.ldc1 = DFF; E.mode = 1; }
                else { g.A = HID; g.Bt = (const bf16*)(ws + WS_WDN + l * 8 * MiB); g.N = DM; g.K = DFF; E.O1 = XN; E.ldc1 = DM; E.mode = (l == DEPTH - 1) ? 3 : 2; E.ssq_in = SSQ0; E.ssq_out = SSQ1; }
                pg8::StaticOrder S; S.init(g.M, g.N, G, cb);
                pg8::gemm_phase<pg8::EpiB, pg8::StaticOrder, true, true>(lds, g, S, E);
            }
        }
        if (ph + 1 < hi) { bar.bar = (unsigned*)(ws + WS_CTL); xcd_barrier(bar); }
    }
}

#ifndef PER_PHASE_LAUNCH
#define PER_PHASE_LAUNCH 0
#endif
extern "C" void kernel_launch(void* const* d_in, const int* in_sizes, int n_in, void* d_out, int out_size, void* d_ws, size_t ws_size, hipStream_t stream) {
    static int grid = 0;
    if (grid == 0) {
        if (n_in != 19 || out_size != M * DM || ws_size < WS_END) { fprintf(stderr, "kernel_launch: unexpected shapes (n_in %d out %d ws %zu)\n", n_in, out_size, ws_size); grid = -1; return; }
        int dev = 0, cus = 0, per_cu = 0;
        if (hipGetDevice(&dev) != hipSuccess || hipDeviceGetAttribute(&cus, hipDeviceAttributeMultiprocessorCount, dev) != hipSuccess) { grid = -1; return; }
        if (hipFuncSetAttribute((const void*)fwd_kernel, hipFuncAttributeMaxDynamicSharedMemorySize, LDS_BYTES) != hipSuccess) { fprintf(stderr, "kernel_launch: hipFuncSetAttribute failed\n"); grid = -1; return; }
        if (hipOccupancyMaxActiveBlocksPerMultiprocessor(&per_cu, (const void*)fwd_kernel, NTHR, LDS_BYTES) != hipSuccess || per_cu < 1) { fprintf(stderr, "kernel_launch: occupancy query says %d\n", per_cu); per_cu = 1; }
        (void)hipGetLastError();
        grid = cus < 256 ? cus : 256;
    }
    if (grid < 0) return;
    (void)hipMemsetAsync((char*)d_ws + WS_CTL, 0, CTL_BYTES, stream);
    Args a{};
    for (int i = 0; i < 19; ++i) a.in[i] = (const float*)d_in[i];
    a.out = (float*)d_out; a.ws = (unsigned char*)d_ws;
#if PER_PHASE_LAUNCH
    for (int ph = 0; ph < NPHASES; ++ph) {
        a.ph_lo = ph; a.ph_hi = ph + 1;
        hipLaunchKernelGGL(fwd_kernel, dim3(grid), dim3(NTHR), LDS_BYTES, stream, a);
    }
#else
    a.ph_lo = 0; a.ph_hi = NPHASES;
    void* params[] = {&a};
    hipError_t e = hipLaunchCooperativeKernel((const void*)fwd_kernel, dim3(grid), dim3(NTHR), params, LDS_BYTES, stream);
    if (e != hipSuccess) fprintf(stderr, "cooperative launch failed: %s (grid %d)\n", hipGetErrorString(e), grid);
#endif
}
```

```cpp
#include <hip/hip_runtime.h>
#include <hip/hip_cooperative_groups.h>
#include <cstdio>
#include <cstdint>
namespace cg = cooperative_groups;
namespace pg8 {
#define PG8_LAS __attribute__((address_space(3)))
typedef unsigned short bf16_t;
typedef short bf16x8 __attribute__((ext_vector_type(8)));
typedef float f32x4 __attribute__((ext_vector_type(4)));
typedef unsigned u32x4 __attribute__((ext_vector_type(4)));
constexpr int BM = 256, BK = 64, HALF = 128, HTB = HALF * BK * 2  , STAGE_BYTES = 8 * HTB, NXCD = 8, WGM = 8;

__host__ __device__ __forceinline__ int lds_byte(int r, int c) { const int st = (r >> 4) * 2 + (c >> 5), rr = r & 15, cc = c & 31, ob = rr * 64 + cc * 2; return st * 1024 + (ob ^ (((ob >> 9) & 1) << 5)); }
__host__ __device__ __forceinline__ void stage_rc(int b, int& R, int& C) { const int st = b / 1024, sb = b % 1024, swz = sb ^ (((sb >> 9) & 1) << 5); R = (st >> 1) * 16 + swz / 64; C = (st & 1) * 32 + (swz % 64) / 2; }
__host__ __device__ __forceinline__ int perm32(int rho) { const int n = rho >> 4, i = rho & 15; return 8 * (i >> 2) + 4 * n + (i & 3); }

struct Unit { int pm, pn; };
struct Gemm { const bf16_t* A; const bf16_t* Bt; int M, N, K; };

struct StaticOrder {
    int nM, nN, nwg, G, c;
    __host__ __device__ void init(int M, int N, int G_, int c_) { nM = M / BM; nN = N / BM; nwg = nM * nN; G = G_; c = c_; }
    __host__ __device__ bool next(int i, Unit& u) const {
        const long L = (long)i * G + c; if (L >= nwg) return false;
        int wgid = (int)L; { const int q = nwg / NXCD, r = nwg % NXCD, xcd = wgid % NXCD, off = wgid / NXCD; wgid = (xcd < r ? xcd * (q + 1) : r * (q + 1) + (xcd - r) * q) + off; }
        const int nig = WGM * nN, gid = wgid / nig, fm = gid * WGM, gsz = (nM - fm) < WGM ? (nM - fm) : WGM;
        u.pm = fm + ((wgid % nig) % gsz); u.pn = (wgid % nig) / gsz; return true;
    }
    __device__ __forceinline__ void a_ready(const Unit&) const {}
    __device__ __forceinline__ void done(const Unit&) const {}
};

typedef float f32x2 __attribute__((ext_vector_type(2)));
typedef __bf16 bf16x2_t __attribute__((ext_vector_type(2)));
__device__ __forceinline__ unsigned cvt_pk_bf16(float lo, float hi) { f32x2 v = {lo, hi}; bf16x2_t b = __builtin_convertvector(v, bf16x2_t); return __builtin_bit_cast(unsigned, b); }
__device__ __forceinline__ float bflo(unsigned u) { return __builtin_bit_cast(float, u << 16); }
__device__ __forceinline__ float bfhi(unsigned u) { return __builtin_bit_cast(float, u & 0xffff0000u); }

#ifndef EPI_ST
#define EPI_ST 0
#endif
__device__ __forceinline__ void st16(void* p, u32x4 v) {
#if EPI_ST == 1
    asm volatile("global_store_dwordx4 %0, %1, off sc1\n\ts_nop 1" :: "v"(p), "v"(v) : "memory");
#elif EPI_ST == 2
    __builtin_nontemporal_store(v, (u32x4*)p);
#else
    *(u32x4*)p = v;
#endif
}
__device__ __forceinline__ float relu_f(float x) { float y; asm("v_max_f32_e32 %0, 0, %1" : "=v"(y) : "v"(x)); return y; }
struct EpiB {
    static constexpr bool PERM = true, AFTER_DRAIN = false, WIDE = true;
    static constexpr int SCR_PITCH = 144, SCR_BYTES = 16 * SCR_PITCH;
    bf16_t* O1; int ldc1; bf16_t* O2; int ldc2; int split_pn; int mode; const float* ssq_in; float* ssq_out; float* outf; PG8_LAS unsigned char* scr;
    template <int MODE>
    __device__ __forceinline__ void body(const f32x4 (&acc)[2][2][4][2], bf16_t* base, int ldc, int rowt, int colw, const float (&rs)[2][4], int pn, int wr, int wc, int fr, int fq) const {
        const int col0 = colw + 8 * fq;
        if (MODE == 3) {
            PG8_LAS unsigned char* wscr3 = scr + (wr * 4 + wc) * SCR_BYTES;
            const int lane3 = fr + 16 * fq, rr3 = lane3 >> 3, ch3 = lane3 & 7;
#pragma unroll
            for (int ai = 0; ai < 2; ++ai)
#pragma unroll
                for (int m = 0; m < 4; ++m) {
                    const int rowg = rowt + ai * HALF + wr * 64 + m * 16;
                    const u32x4 hl0 = *(const u32x4*)(base + (size_t)(rowg + rr3) * ldc + colw + 8 * ch3), hl1 = *(const u32x4*)(base + (size_t)(rowg + 8 + rr3) * ldc + colw + 8 * ch3);
                    *(PG8_LAS u32x4*)(wscr3 + rr3 * SCR_PITCH + ch3 * 16) = hl0; *(PG8_LAS u32x4*)(wscr3 + (rr3 + 8) * SCR_PITCH + ch3 * 16) = hl1;
                    u32x4 hb[2]; hb[0] = *(const PG8_LAS u32x4*)(wscr3 + fr * SCR_PITCH + fq * 16); hb[1] = *(const PG8_LAS u32x4*)(wscr3 + fr * SCR_PITCH + fq * 16 + 64);
#pragma unroll
                    for (int bj = 0; bj < 2; ++bj) {
                        const u32x4 h = hb[bj];
                        f32x4 v0 = acc[ai][bj][m][0] * rs[ai][m], v1 = acc[ai][bj][m][1] * rs[ai][m];
                        v0[0] += bflo(h.x); v0[1] += bfhi(h.x); v0[2] += bflo(h.y); v0[3] += bfhi(h.y);
                        v1[0] += bflo(h.z); v1[1] += bfhi(h.z); v1[2] += bflo(h.w); v1[3] += bfhi(h.w);
                        *(PG8_LAS f32x4*)(wscr3 + fr * SCR_PITCH + fq * 32) = v0; *(PG8_LAS f32x4*)(wscr3 + fr * SCR_PITCH + fq * 32 + 16) = v1;
                        const f32x4 o0 = *(const PG8_LAS f32x4*)(wscr3 + rr3 * SCR_PITCH + ch3 * 16), o1 = *(const PG8_LAS f32x4*)(wscr3 + (rr3 + 8) * SCR_PITCH + ch3 * 16);
                        float* op = outf + (size_t)(rowg + rr3) * ldc + colw + 32 * bj + 4 * ch3;
                        *(f32x4*)op = o0; *(f32x4*)(op + (size_t)8 * ldc) = o1;
                    }
                }
            return;
        }
        PG8_LAS unsigned char* wscr = scr + (wr * 4 + wc) * SCR_BYTES;
        PG8_LAS unsigned char* wp = wscr + fr * SCR_PITCH + fq * 16;
        const int lane = fr + 16 * fq, rr = lane >> 3, ch = lane & 7;
        const PG8_LAS unsigned char* rp = wscr + rr * SCR_PITCH + ch * 16;
#pragma unroll
        for (int ai = 0; ai < 2; ++ai) {
            u32x4 hl[4][2];
            if (MODE == 2) {
#pragma unroll
                for (int m = 0; m < 4; ++m)
#pragma unroll
                    for (int k = 0; k < 2; ++k) hl[m][k] = *(const u32x4*)(base + (size_t)(rowt + ai * HALF + wr * 64 + m * 16 + 8 * k + rr) * ldc + colw + 8 * ch);
            }
#pragma unroll
            for (int m = 0; m < 4; ++m) {
                const int rowg = rowt + ai * HALF + wr * 64 + m * 16;
                float ss = 0.f;
                u32x4 hb[2];
                if (MODE == 2) {
                    *(PG8_LAS u32x4*)(wscr + rr * SCR_PITCH + ch * 16) = hl[m][0]; *(PG8_LAS u32x4*)(wscr + (rr + 8) * SCR_PITCH + ch * 16) = hl[m][1];
                    hb[0] = *(const PG8_LAS u32x4*)wp; hb[1] = *(const PG8_LAS u32x4*)(wp + 64);
                }
#pragma unroll
                for (int bj = 0; bj < 2; ++bj) {
                    f32x4 v0 = acc[ai][bj][m][0], v1 = acc[ai][bj][m][1];
                    if (MODE == 0) { v0 = v0 * rs[ai][m]; v1 = v1 * rs[ai][m]; }
                    else if (MODE == 1) {
#pragma unroll
                        for (int e = 0; e < 4; ++e) { const float x = relu_f(v0[e]); v0[e] = x * x; const float y = relu_f(v1[e]); v1[e] = y * y; } }
                    else { const u32x4 h = hb[bj]; v0 = v0 * rs[ai][m]; v1 = v1 * rs[ai][m];
                        v0[0] += bflo(h.x); v0[1] += bfhi(h.x); v0[2] += bflo(h.y); v0[3] += bfhi(h.y);
                        v1[0] += bflo(h.z); v1[1] += bfhi(h.z); v1[2] += bflo(h.w); v1[3] += bfhi(h.w); }
                    u32x4 w; w.x = cvt_pk_bf16(v0[0], v0[1]); w.y = cvt_pk_bf16(v0[2], v0[3]); w.z = cvt_pk_bf16(v1[0], v1[1]); w.w = cvt_pk_bf16(v1[2], v1[3]);
                    if (MODE == 2) { const float r0 = bflo(w.x), r1 = bfhi(w.x), r2 = bflo(w.y), r3 = bfhi(w.y), r4 = bflo(w.z), r5 = bfhi(w.z), r6 = bflo(w.w), r7 = bfhi(w.w);
                        ss += ((r0 * r0 + r1 * r1) + (r2 * r2 + r3 * r3)) + ((r4 * r4 + r5 * r5) + (r6 * r6 + r7 * r7)); }
                    *(PG8_LAS u32x4*)(wp + 64 * bj) = w;
                }
                const u32x4 l0 = *(const PG8_LAS u32x4*)rp, l1 = *(const PG8_LAS u32x4*)(rp + 8 * SCR_PITCH);
                bf16_t* gp = base + (size_t)(rowg + rr) * ldc + colw + 8 * ch;
                st16(gp, l0); st16(gp + (size_t)8 * ldc, l1);
                if (MODE == 2) {
                    ss += __shfl_xor(ss, 16); ss += __shfl_xor(ss, 32);
                    if (fq == 0) ssq_out[(size_t)(rowg + fr) * 16 + pn * 4 + wc] = ss;
                }
            }
        }
    }
    __device__ __forceinline__ void operator()(const f32x4 (&acc)[2][2][4][2], const Unit& u, int wr, int wc, int fr, int fq) const {
        const int row0 = u.pm * BM + wr * 64 + fr;
        bf16_t* base = O1; int ldc = ldc1; int colt = u.pn * BM;
        if (u.pn >= split_pn) { base = O2; ldc = ldc2; colt = (u.pn - split_pn) * BM; }
        const int colw = colt + wc * 64;
        float rs[2][4];
        if (ssq_in) {
            const int lane = fr + 16 * fq, rq = lane >> 2, cq = lane & 3;
            f32x4 q[2][4];
#pragma unroll
            for (int ai = 0; ai < 2; ++ai)
#pragma unroll
                for (int m = 0; m < 4; ++m) q[ai][m] = *(const f32x4*)(ssq_in + (size_t)(u.pm * BM + ai * HALF + wr * 64 + m * 16 + rq) * 16 + 4 * cq);
#pragma unroll
            for (int ai = 0; ai < 2; ++ai)
#pragma unroll
                for (int m = 0; m < 4; ++m) { float t = (q[ai][m][0] + q[ai][m][1]) + (q[ai][m][2] + q[ai][m][3]); t += __shfl_xor(t, 1); t += __shfl_xor(t, 2);
                    const float tr = __shfl(t, 4 * fr);
                    const float r = __builtin_amdgcn_rsqf(tr * (1.0f / 1024.0f) + 1e-6f); rs[ai][m] = (mode >= 2) ? r * r : r; }
        } else {
#pragma unroll
            for (int ai = 0; ai < 2; ++ai)
#pragma unroll
                for (int m = 0; m < 4; ++m) rs[ai][m] = 1.0f;
        }
        const int rowt = u.pm * BM;
        if (mode == 1) body<1>(acc, base, ldc, rowt, colw, rs, u.pn, wr, wc, fr, fq);
        else if (mode == 0) body<0>(acc, base, ldc, rowt, colw, rs, u.pn, wr, wc, fr, fq);
        else if (mode == 2) body<2>(acc, base, ldc, rowt, colw, rs, u.pn, wr, wc, fr, fq);
        else body<3>(acc, base, ldc, rowt, colw, rs, u.pn, wr, wc, fr, fq);
    }
};

template <class Epi, class Sched, bool ALIGN_EPI = false, bool SP2 = false>
__device__ __forceinline__ void gemm_phase(PG8_LAS unsigned char* lds, const Gemm g, const Sched& S, const Epi& E) {
    int tid_ = threadIdx.x; asm volatile("" : "+v"(tid_));
    const int tid = tid_, wid = __builtin_amdgcn_readfirstlane(tid >> 6), lane = tid & 63, wr = wid >> 2, wc = wid & 3, fr = lane & 15, fq = lane >> 4;
    const int K = g.K, nt = K / BK;
    unsigned voffA[2], voffB[2];
#pragma unroll
    for (int i = 0; i < 2; ++i) { int R, C; stage_rc(tid * 16 + i * 8192, R, C); const int Rb = Epi::PERM ? (Epi::WIDE ? (64 * (R >> 5) + perm32(R & 31)) : ((R & ~31) + perm32(R & 31))) : R;
        voffA[i] = (unsigned)(R * K + C) * 2u; voffB[i] = (unsigned)(Rb * K + C) * 2u; }
    const size_t kstep = (size_t)(BK * 2);
    const size_t hstep = (size_t)HALF * K * 2;
    const size_t tstep = 2 * hstep;
    const size_t hstepB = (Epi::PERM && Epi::WIDE) ? (size_t)32 * K * 2 : hstep;
    const unsigned ldsw = (unsigned)wid * 1024u;
    const int aoff = lds_byte(wr * 64 + fr, fq * 8), boff = lds_byte(wc * 32 + fr, fq * 8);
#define PG8_SA(b, h) (((b) * 2 + (h)) * HTB)
#define PG8_SB(b, h) ((4 + (b) * 2 + (h)) * HTB)
#define PG8_STAGE(bufoff, gbase, voff) do { _Pragma("unroll") for (int _i = 0; _i < 2; ++_i) \
        __builtin_amdgcn_global_load_lds((const unsigned*)((const char*)(gbase) + (voff)[_i]), (PG8_LAS unsigned*)(lds + (bufoff) + ldsw + _i * 8192), 16, 0, 0); } while (0)
#define PG8_LDA(dst, b, h) do { _Pragma("unroll") for (int m = 0; m < 4; ++m) _Pragma("unroll") for (int k = 0; k < 2; ++k) dst[m][k] = *(const PG8_LAS bf16x8*)(lds + PG8_SA(b, h) + aoff + m * 2048 + k * 1024); } while (0)
#define PG8_LDB(dst, b, h) do { _Pragma("unroll") for (int n = 0; n < 2; ++n) _Pragma("unroll") for (int k = 0; k < 2; ++k) dst[n][k] = *(const PG8_LAS bf16x8*)(lds + PG8_SB(b, h) + boff + n * 2048 + k * 1024); } while (0)
#define PG8_MMA(ai, bj, At, Bt) do { __builtin_amdgcn_s_setprio(1); _Pragma("unroll") for (int m = 0; m < 4; ++m) _Pragma("unroll") for (int n = 0; n < 2; ++n) _Pragma("unroll") for (int k = 0; k < 2; ++k) \
        acc[ai][bj][m][n] = __builtin_amdgcn_mfma_f32_16x16x32_bf16(Bt[n][k], At[m][k], acc[ai][bj][m][n], 0, 0, 0); __builtin_amdgcn_s_setprio(0); } while (0)
#define PG8_WAIT_V(n) asm volatile("s_waitcnt vmcnt(" #n ")" ::: "memory")
#define PG8_WAIT_L(n) asm volatile("s_waitcnt lgkmcnt(" #n ")" ::: "memory")
#define PG8_BAR __builtin_amdgcn_s_barrier()
#define PG8_SCHED __builtin_amdgcn_sched_barrier(0)
    Unit cur, nxt; int ui = 0;
    if (!S.next(0, cur)) return;
    f32x4 acc[2][2][4][2];
#pragma unroll
    for (int a = 0; a < 2; ++a)
#pragma unroll
        for (int b = 0; b < 2; ++b)
#pragma unroll
            for (int m = 0; m < 4; ++m)
#pragma unroll
                for (int n = 0; n < 2; ++n) acc[a][b][m][n] = (f32x4){0.f, 0.f, 0.f, 0.f};
    bf16x8 At[4][2], B0[2][2], B1[2][2];
    const char* cA = (const char*)g.A + (size_t)cur.pm * tstep; const char* cB = (const char*)g.Bt + (size_t)cur.pn * tstep;
    S.a_ready(cur);
    if constexpr (SP2) {
        PG8_STAGE(PG8_SB(0, 0), cB, voffB); PG8_STAGE(PG8_SB(0, 1), cB + hstepB, voffB); PG8_STAGE(PG8_SA(0, 0), cA, voffA); PG8_STAGE(PG8_SA(0, 1), cA + hstep, voffA);
        if (wr == 1) PG8_BAR;
        PG8_WAIT_V(2); PG8_BAR;
        PG8_STAGE(PG8_SB(1, 0), cB + kstep, voffB); PG8_STAGE(PG8_SA(1, 0), cA + kstep, voffA); PG8_STAGE(PG8_SB(1, 1), cB + hstepB + kstep, voffB);
        PG8_WAIT_V(6); PG8_BAR;
    } else {
        PG8_STAGE(PG8_SB(0, 0), cB, voffB); PG8_STAGE(PG8_SA(0, 0), cA, voffA); PG8_STAGE(PG8_SB(0, 1), cB + hstepB, voffB); PG8_STAGE(PG8_SA(0, 1), cA + hstep, voffA);
        if (wr == 1) PG8_BAR;
        PG8_WAIT_V(4); PG8_BAR;
        PG8_STAGE(PG8_SB(1, 0), cB + kstep, voffB); PG8_STAGE(PG8_SA(1, 0), cA + kstep, voffA); PG8_STAGE(PG8_SB(1, 1), cB + hstepB + kstep, voffB);
        PG8_WAIT_V(6); PG8_BAR;
    }
    for (;;) {
        const bool has_next = S.next(ui + 1, nxt);
        const char* nA = has_next ? (const char*)g.A + (size_t)nxt.pm * tstep : cA; const char* nB = has_next ? (const char*)g.Bt + (size_t)nxt.pn * tstep : cB;
        for (int t = 0; t < nt; t += 2) {
            const bool last = (t == nt - 2);
            const char* a1 = cA + (size_t)(t + 1) * kstep;
            const char* a2 = last ? nA : cA + (size_t)(t + 2) * kstep; const char* b2 = last ? nB : cB + (size_t)(t + 2) * kstep;
            const char* a3 = a2 + kstep; const char* b3 = b2 + kstep;
            if (last && has_next) S.a_ready(nxt);
            if constexpr (SP2) {
            PG8_LDB(B0, 0, 0); PG8_LDB(B1, 0, 1); PG8_SCHED; PG8_LDA(At, 0, 0); PG8_STAGE(PG8_SA(1, 1), a1 + hstep, voffA);
            PG8_WAIT_V(8); PG8_WAIT_L(0); PG8_BAR; PG8_MMA(0, 0, At, B0); PG8_MMA(0, 1, At, B1); PG8_BAR; PG8_SCHED;
            PG8_LDA(At, 0, 1); PG8_STAGE(PG8_SB(0, 0), b2, voffB); PG8_STAGE(PG8_SB(0, 1), b2 + hstepB, voffB); PG8_STAGE(PG8_SA(0, 0), a2, voffA);
            PG8_WAIT_V(8); PG8_WAIT_L(0); PG8_BAR; PG8_MMA(1, 0, At, B0); PG8_MMA(1, 1, At, B1); PG8_BAR; PG8_SCHED;
            PG8_LDB(B0, 1, 0); PG8_LDB(B1, 1, 1); PG8_SCHED; PG8_LDA(At, 1, 0); PG8_STAGE(PG8_SA(0, 1), a2 + hstep, voffA);
            PG8_WAIT_V(8); PG8_WAIT_L(0); PG8_BAR; PG8_MMA(0, 0, At, B0); PG8_MMA(0, 1, At, B1); PG8_BAR; PG8_SCHED;
            PG8_LDA(At, 1, 1); PG8_STAGE(PG8_SB(1, 0), b3, voffB); PG8_STAGE(PG8_SB(1, 1), b3 + hstepB, voffB); PG8_STAGE(PG8_SA(1, 0), a3, voffA);
            PG8_WAIT_V(8); PG8_WAIT_L(0); PG8_BAR; PG8_MMA(1, 0, At, B0); PG8_MMA(1, 1, At, B1); PG8_BAR; PG8_SCHED;
            } else {
            PG8_LDB(B0, 0, 0); PG8_SCHED; PG8_LDA(At, 0, 0); PG8_STAGE(PG8_SA(1, 1), a1 + hstep, voffA);
            PG8_WAIT_L(8); PG8_BAR; PG8_WAIT_L(0); PG8_MMA(0, 0, At, B0); PG8_BAR; PG8_SCHED;
            PG8_LDB(B1, 0, 1); PG8_STAGE(PG8_SB(0, 0), b2, voffB);
            PG8_BAR; PG8_WAIT_L(0); PG8_MMA(0, 1, At, B1); PG8_BAR;
            PG8_LDA(At, 0, 1); PG8_STAGE(PG8_SA(0, 0), a2, voffA);
            PG8_BAR; PG8_WAIT_L(0); PG8_MMA(1, 0, At, B0); PG8_BAR; PG8_SCHED;
            PG8_STAGE(PG8_SB(0, 1), b2 + hstepB, voffB);
            PG8_WAIT_V(6); PG8_BAR; PG8_MMA(1, 1, At, B1); PG8_BAR;
            PG8_LDB(B0, 1, 0); PG8_SCHED; PG8_LDA(At, 1, 0); PG8_STAGE(PG8_SA(0, 1), a2 + hstep, voffA);
            PG8_WAIT_L(8); PG8_BAR; PG8_WAIT_L(0); PG8_MMA(0, 0, At, B0); PG8_BAR; PG8_SCHED;
            PG8_LDB(B1, 1, 1); PG8_STAGE(PG8_SB(1, 0), b3, voffB);
            PG8_BAR; PG8_WAIT_L(0); PG8_MMA(0, 1, At, B1); PG8_BAR;
            PG8_LDA(At, 1, 1); PG8_STAGE(PG8_SA(1, 0), a3, voffA);
            PG8_BAR; PG8_WAIT_L(0); PG8_MMA(1, 0, At, B0); PG8_BAR; PG8_SCHED;
            PG8_STAGE(PG8_SB(1, 1), b3 + hstepB, voffB);
            PG8_WAIT_V(6); PG8_BAR; PG8_MMA(1, 1, At, B1); PG8_BAR;
            }
        }
        if constexpr (ALIGN_EPI) { if (wr == 0) PG8_BAR; }
        if constexpr (!Epi::AFTER_DRAIN) { E(acc, cur, wr, wc, fr, fq); S.done(cur); }
        if (!has_next) break;
#pragma unroll
        for (int a = 0; a < 2; ++a)
#pragma unroll
            for (int b = 0; b < 2; ++b)
#pragma unroll
                for (int m = 0; m < 4; ++m)
#pragma unroll
                    for (int n = 0; n < 2; ++n) acc[a][b][m][n] = (f32x4){0.f, 0.f, 0.f, 0.f};
        cur = nxt; cA = nA; cB = nB; ++ui;
        if constexpr (ALIGN_EPI) { if (wr == 1) PG8_BAR; }
    }
    PG8_WAIT_V(0);
    if constexpr (!ALIGN_EPI) { if (wr == 0) PG8_BAR; }
    PG8_BAR;
    if constexpr (Epi::AFTER_DRAIN) { E.fused(acc, cur, wr, wc, fr, fq, lds, wid, lane); S.done(cur); }
#undef PG8_SA
#undef PG8_SB
#undef PG8_STAGE
#undef PG8_LDA
#undef PG8_LDB
#undef PG8_MMA
#undef PG8_WAIT_V
#undef PG8_WAIT_L
#undef PG8_BAR
#undef PG8_SCHED
}
}

constexpr int NWAVES = 8, NTHR = 512;
constexpr int DM = 1024, BATCH = 8, SEQ = 4096, DEPTH = 4, NA = 2;
constexpr int M = BATCH * SEQ;
constexpr int HD = 64, MEMLEN = 256, MAINW = 768, DFF = 4096;
constexpr int MROWS = BATCH * MEMLEN;
constexpr float EPS = 1e-6f;
constexpr float LOG2E = 1.4426950408889634f;

constexpr size_t MiB = 1u << 20;
constexpr size_t WS_WIN = 0;
constexpr size_t WS_WOUT = 12 * MiB;
constexpr size_t WS_WUP = 20 * MiB;
constexpr size_t WS_WDN = 52 * MiB;
constexpr size_t WS_WMKV = 84 * MiB;
constexpr size_t WS_WPOOL = 88 * MiB;
constexpr size_t WS_MEMN = 92 * MiB;
constexpr size_t WS_MKV = 96 * MiB;
constexpr size_t WS_KV = 104 * MiB;
constexpr size_t WS_XN = 136 * MiB;
constexpr size_t WS_BIG = 200 * MiB;
constexpr size_t WS_CTL = 456 * MiB;
constexpr size_t CTL_BYTES = 65536;
constexpr size_t WS_SSQ = 457 * MiB;
constexpr size_t WS_END = 461 * MiB;

constexpr int LDS_BYTES = 155648;
constexpr int EPI_SCR_OFF = 135168;
constexpr int MISC_OFF = 131072;

#define LAS __attribute__((address_space(3)))
typedef unsigned short bf16;
typedef unsigned v4u __attribute__((ext_vector_type(4)));
typedef unsigned v2u __attribute__((ext_vector_type(2)));
typedef float f32x4 __attribute__((ext_vector_type(4)));
typedef float f32x16 __attribute__((ext_vector_type(16)));
typedef short bf16x8 __attribute__((ext_vector_type(8)));
typedef short s16x4 __attribute__((ext_vector_type(4)));
#define LDS_WAIT() asm volatile("s_waitcnt lgkmcnt(0)" ::: "memory")
__device__ __forceinline__ unsigned pk2(float lo, float hi) { return pg8::cvt_pk_bf16(lo, hi); }
__device__ __forceinline__ float bf_lo(unsigned u) { return __uint_as_float(u << 16); }
__device__ __forceinline__ float bf_hi(unsigned u) { return __uint_as_float(u & 0xffff0000u); }
__device__ __forceinline__ void unpack8(const v4u r, float* f) { f[0] = bf_lo(r.x); f[1] = bf_hi(r.x); f[2] = bf_lo(r.y); f[3] = bf_hi(r.y); f[4] = bf_lo(r.z); f[5] = bf_hi(r.z); f[6] = bf_lo(r.w); f[7] = bf_hi(r.w); }
__device__ __forceinline__ v4u pack8(const float* f) { v4u o; o.x = pk2(f[0], f[1]); o.y = pk2(f[2], f[3]); o.z = pk2(f[4], f[5]); o.w = pk2(f[6], f[7]); return o; }
__device__ __forceinline__ float wave_sum(float v) {
#pragma unroll
    for (int o = 1; o < 64; o <<= 1) v += __shfl_xor(v, o);
    return v;
}
#define XB_TMO      128
#define XB_XCNT(j)  (256  + 64 * (j))
#define XB_XSUB(j)  (1280 + 64 * (j))
#define XB_XGEN(j)  (2304 + 64 * (j))
#define XB_TOP      3328
#define XB_TOPGEN   3392
#define XCD_BAR_WORDS 3456
#define XB_SPIN_CAP (1u << 18)

__device__ __forceinline__ unsigned xb_ld(unsigned* p)              { return __hip_atomic_load(p, __ATOMIC_RELAXED, __HIP_MEMORY_SCOPE_AGENT); }
__device__ __forceinline__ unsigned xb_add(unsigned* p, unsigned v) { return __hip_atomic_fetch_add(p, v, __ATOMIC_RELAXED, __HIP_MEMORY_SCOPE_AGENT); }
__device__ __forceinline__ unsigned xb_xcc_id() { return (unsigned)__builtin_amdgcn_s_getreg((3 << 11) | 20) & 0xFu; }
#define XB_SPIN(cond, bar) do { unsigned _sp = 0; while (cond) { __builtin_amdgcn_s_sleep(1); \
    if ((++_sp & 255u) == 0u) { if (xb_ld(&(bar)[XB_TMO])) break; if (_sp > XB_SPIN_CAP) { atomicAdd(&(bar)[XB_TMO], 1u); break; } } } } while (0)

struct XcdBarrier {
    unsigned* bar; unsigned x;
    volatile LAS unsigned* st;
};

__device__ __forceinline__ XcdBarrier xcd_barrier_post(unsigned* bar, volatile LAS unsigned* st) {
    XcdBarrier b; b.bar = bar; b.x = xb_xcc_id(); b.st = st;
    if (threadIdx.x == 0) (void)xb_add(&bar[XB_XCNT(b.x)], 1u);
    return b;
}
__device__ __forceinline__ void xcd_barrier_complete(unsigned* bar, unsigned x, unsigned& nloc, unsigned& nx) {
    const unsigned G = gridDim.x * gridDim.y * gridDim.z;
    unsigned sum, cnt, mine, sp = 0u;
    for (;;) {
        sum = 0u; cnt = 0u; mine = 0u;
#pragma unroll
        for (unsigned j = 0; j < 16; ++j) { const unsigned c = xb_ld(&bar[XB_XCNT(j)]); sum += c; cnt += (c > 0u) ? 1u : 0u; mine = (j == x) ? c : mine; }
        if (sum == G) break;
        __builtin_amdgcn_s_sleep(1);
        if ((++sp & 255u) == 0u) { if (xb_ld(&bar[XB_TMO])) break; if (sp > XB_SPIN_CAP) { atomicAdd(&bar[XB_TMO], 1u); break; } }
    }
    nloc = mine > 0u ? mine : 1u; nx = cnt > 0u ? cnt : 1u;
}

__device__ __forceinline__ void xcd_barrier(const XcdBarrier& b) {
    asm volatile("s_waitcnt vmcnt(0)" ::: "memory");
    __syncthreads();
    if (threadIdx.x == 0) {
        unsigned* bar = b.bar;
        __builtin_amdgcn_s_waitcnt(0);
        unsigned nloc = b.st[0], nx = b.st[1];
        if (nloc == 0u) { xcd_barrier_complete(bar, b.x, nloc, nx); b.st[0] = nloc; b.st[1] = nx; }
        const unsigned old = xb_add(&bar[XB_XSUB(b.x)], 1u);
        const unsigned gen = old / nloc;
        if (old + 1u == (gen + 1u) * nloc) {
            __builtin_amdgcn_fence(__ATOMIC_RELEASE, "agent");
            asm volatile("s_waitcnt vmcnt(0)" ::: "memory");
            const unsigned og = xb_add(&bar[XB_TOP], 1u);
            const unsigned tg = og / nx;
            if (og + 1u == (tg + 1u) * nx) xb_add(&bar[XB_TOPGEN], 1u);
            else XB_SPIN(xb_ld(&bar[XB_TOPGEN]) == tg, bar);
            __builtin_amdgcn_fence(__ATOMIC_ACQUIRE, "agent");
            xb_add(&bar[XB_XGEN(b.x)], 1u);
            asm volatile("s_waitcnt vmcnt(0)" ::: "memory");
        } else {
            XB_SPIN(xb_ld(&bar[XB_XGEN(b.x)]) == gen, bar);
            __builtin_amdgcn_fence(__ATOMIC_ACQUIRE, "agent");
            asm volatile("s_waitcnt vmcnt(0)" ::: "memory");
        }
    }
    __syncthreads();
}

namespace att {
constexpr int KP = 144;
constexpr int OS_PITCH = 144, OS_BYTES = 32 * OS_PITCH;
__device__ __forceinline__ int crow(int r, int hi) { return (r & 3) + 8 * (r >> 2) + 4 * hi; }

struct StageRegs { v4u kr[6], va[3], vb[3]; };
template <int NKEYS>
__device__ __forceinline__ void stage_load(StageRegs& R, const bf16* ksrc, const bf16* vsrc, int pitch, int first_valid, int tid) {
    constexpr int NK = NKEYS * 8 / NTHR, NV = NKEYS * 4 / NTHR;
    const int c = tid & 7, r0 = tid >> 3;
#pragma unroll
    for (int it = 0; it < NK; ++it) { const int row = r0 + it * (NTHR / 8); R.kr[it] = (v4u){0u, 0u, 0u, 0u}; if (row >= first_valid) R.kr[it] = *(const v4u*)(ksrc + (long)row * pitch + 8 * c); }
#pragma unroll
    for (int it = 0; it < NV; ++it) { const int kp = r0 + it * (NTHR / 8); R.va[it] = (v4u){0u, 0u, 0u, 0u}; R.vb[it] = R.va[it];
        if (2 * kp >= first_valid) { R.va[it] = *(const v4u*)(vsrc + (long)(2 * kp) * pitch + 8 * c); R.vb[it] = *(const v4u*)(vsrc + (long)(2 * kp + 1) * pitch + 8 * c); } }
#pragma unroll
    for (int it = NK; it < 6; ++it) R.kr[it] = (v4u){0u, 0u, 0u, 0u};
#pragma unroll
    for (int it = NV; it < 3; ++it) { R.va[it] = (v4u){0u, 0u, 0u, 0u}; R.vb[it] = (v4u){0u, 0u, 0u, 0u}; }
}
template <int NKEYS, int VP>
__device__ __forceinline__ void stage_write(const StageRegs& R, LAS unsigned char* Kl, LAS unsigned char* Vt, const float* gain, int tid) {
    constexpr int NK = NKEYS * 8 / NTHR, NV = NKEYS * 4 / NTHR;
    const int c = tid & 7, r0 = tid >> 3;
    float g[8];
#pragma unroll
    for (int i = 0; i < 8; ++i) g[i] = gain[8 * c + i];
#pragma unroll
    for (int it = 0; it < NK; ++it) {
        const int row = r0 + it * (NTHR / 8);
        float f[8]; unpack8(R.kr[it], f);
        float ss = 0.f;
#pragma unroll
        for (int i = 0; i < 8; ++i) ss += f[i] * f[i];
        ss += __shfl_xor(ss, 1); ss += __shfl_xor(ss, 2); ss += __shfl_xor(ss, 4);
        const float rstd = __builtin_amdgcn_rsqf(ss * (1.0f / 64.0f) + EPS);
#pragma unroll
        for (int i = 0; i < 8; ++i) f[i] = f[i] * rstd * g[i];
        *(LAS v4u*)(Kl + row * KP + 16 * c) = pack8(f);
    }
#pragma unroll
    for (int it = 0; it < NV; ++it) {
        const int kp = r0 + it * (NTHR / 8);
        const v4u a = R.va[it], b = R.vb[it];
        LAS unsigned char* p = Vt + (8 * c) * VP + 4 * kp;
        *(LAS unsigned*)(p + 0 * VP) = (a.x & 0xffffu) | (b.x << 16);
        *(LAS unsigned*)(p + 1 * VP) = (a.x >> 16) | (b.x & 0xffff0000u);
        *(LAS unsigned*)(p + 2 * VP) = (a.y & 0xffffu) | (b.y << 16);
        *(LAS unsigned*)(p + 3 * VP) = (a.y >> 16) | (b.y & 0xffff0000u);
        *(LAS unsigned*)(p + 4 * VP) = (a.z & 0xffffu) | (b.z << 16);
        *(LAS unsigned*)(p + 5 * VP) = (a.z >> 16) | (b.z & 0xffff0000u);
        *(LAS unsigned*)(p + 6 * VP) = (a.w & 0xffffu) | (b.w << 16);
        *(LAS unsigned*)(p + 7 * VP) = (a.w >> 16) | (b.w & 0xffff0000u);
    }
}
struct QRaw { v4u r[4]; };
__device__ __forceinline__ void q_load(QRaw& q, const bf16* Q, int qpitch, int lane) {
    const bf16* qp = Q + (long)(lane & 31) * qpitch + 8 * (lane >> 5);
#pragma unroll
    for (int s = 0; s < 4; ++s) q.r[s] = *(const v4u*)(qp + 16 * s);
}
struct QLine { v4u r[4]; };
__device__ __forceinline__ void q_load_lines(QLine& q, const bf16* Q, int qpitch, int lane) {
    const bf16* qp = Q + (long)(lane >> 3) * qpitch + 8 * (lane & 7);
#pragma unroll
    for (int k = 0; k < 4; ++k) q.r[k] = *(const v4u*)(qp + (long)(8 * k) * qpitch);
}
__device__ __forceinline__ void q_redistribute(const QLine& ql, QRaw& q, LAS unsigned char* stage, int lane) {
#pragma unroll
    for (int k = 0; k < 4; ++k) *(LAS v4u*)(stage + (8 * k + (lane >> 3)) * OS_PITCH + 16 * (lane & 7)) = ql.r[k];
#pragma unroll
    for (int s = 0; s < 4; ++s) q.r[s] = *(const LAS v4u*)(stage + (lane & 31) * OS_PITCH + (2 * s + (lane >> 5)) * 16);
}
__device__ __forceinline__ void q_gains(const float* gq, int lane, f32x4 (&gv)[8]) {
#pragma unroll
    for (int s = 0; s < 4; ++s) { gv[2 * s] = *(const f32x4*)(gq + 16 * s + 8 * (lane >> 5)); gv[2 * s + 1] = *(const f32x4*)(gq + 16 * s + 8 * (lane >> 5) + 4); }
}
__device__ __forceinline__ void q_norm(const QRaw& q, const f32x4 (&gv)[8], int lane, bf16x8 (&qf)[4]) {
    float f[4][8]; float ss = 0.f;
#pragma unroll
    for (int s = 0; s < 4; ++s) { unpack8(q.r[s], f[s]);
#pragma unroll
        for (int j = 0; j < 8; ++j) ss += f[s][j] * f[s][j]; }
    ss += __shfl_xor(ss, 32);
    const float rstd = (0.125f * LOG2E) * __builtin_amdgcn_rsqf(ss * (1.0f / 64.0f) + EPS);
#pragma unroll
    for (int s = 0; s < 4; ++s) {
#pragma unroll
        for (int j = 0; j < 8; ++j) f[s][j] = f[s][j] * rstd * gv[2 * s + (j >> 2)][j & 3];
        qf[s] = __builtin_bit_cast(bf16x8, pack8(f[s]));
    }
}
__device__ __forceinline__ float score_bound2(const float* gq, const float* gk, int lane) {
    float a = fabsf(gq[lane]), b = fabsf(gk[lane]);
#pragma unroll
    for (int o = 1; o < 64; o <<= 1) { a = fmaxf(a, __shfl_xor(a, o)); b = fmaxf(b, __shfl_xor(b, o)); }
    return 8.1f * a * b * LOG2E;
}
template <int NKT, bool SWA, int VP, int NH>
__device__ __forceinline__ void task(LAS const unsigned char* Kl, LAS const unsigned char* Vt, const bf16x8 (&qf)[NH][4],
                                     bf16* const (&O)[NH], int opitch, const float (&slope2)[NH], const float (&sink2)[NH], const float (&shift2)[NH], int kt_first, int lane, LAS unsigned char* oscr) {
    const int ql = lane & 31, hi = lane >> 5;
    int qh = ql - 4 * hi; asm volatile("" : "+v"(qh));
    float base[NH];
#pragma unroll
    for (int h = 0; h < NH; ++h) { base[h] = -shift2[h]; if (SWA) base[h] -= slope2[h] * (float)(qh + 128); }
    const short one = (ql == 0) ? (short)0x3F80 : (short)0;
    const bf16x8 onesf = (bf16x8){one, one, one, one, one, one, one, one};
    constexpr bool ONES = (NH == 1);
    f32x16 Oa[NH][ONES ? 3 : 2]; float vsum[NH];
#pragma unroll
    for (int h = 0; h < NH; ++h) { vsum[h] = 0.f; Oa[h][0] = (f32x16){0.f, 0.f, 0.f, 0.f, 0.f, 0.f, 0.f, 0.f, 0.f, 0.f, 0.f, 0.f, 0.f, 0.f, 0.f, 0.f}; Oa[h][1] = Oa[h][0]; if (ONES) Oa[h][ONES ? 2 : 0] = Oa[h][0]; }
#pragma unroll
    for (int kt = 0; kt < NKT; ++kt) {
        if (SWA && kt < kt_first) continue;
        f32x16 S[NH];
#pragma unroll
        for (int h = 0; h < NH; ++h)
#pragma unroll
            for (int r = 0; r < 16; ++r) {
                const int cr = (r & 3) + 8 * (r >> 2);
                float c = base[h];
                if (SWA) {
                    c = fmaf(slope2[h], (float)(32 * kt + cr), base[h]);
                    if (kt == 0) c = (cr > qh) ? c : -1e30f;
                    if (kt == NKT - 1) c = (cr <= qh) ? c : -1e30f;
                }
                S[h][r] = c;
            }
        __builtin_amdgcn_s_setprio(1);
#pragma unroll
        for (int s = 0; s < 4; ++s) {
            const bf16x8 kf = *(LAS const bf16x8*)(Kl + (32 * kt + ql) * KP + (16 * s + 8 * hi) * 2);
#pragma unroll
            for (int h = 0; h < NH; ++h) S[h] = __builtin_amdgcn_mfma_f32_32x32x16_bf16(kf, qf[h][s], S[h], 0, 0, 0);
        }
        __builtin_amdgcn_s_setprio(0);
#pragma unroll
        for (int h = 0; h < NH; ++h)
#pragma unroll
            for (int r = 0; r < 16; ++r) { S[h][r] = __builtin_amdgcn_exp2f(S[h][r]); if (!ONES) vsum[h] += S[h][r]; }
#pragma unroll
        for (int s = 0; s < 2; ++s) {
            bf16x8 pf[NH];
#pragma unroll
            for (int h = 0; h < NH; ++h) { v4u pw; pw.x = pk2(S[h][8 * s + 0], S[h][8 * s + 1]); pw.y = pk2(S[h][8 * s + 2], S[h][8 * s + 3]);
                pw.z = pk2(S[h][8 * s + 4], S[h][8 * s + 5]); pw.w = pk2(S[h][8 * s + 6], S[h][8 * s + 7]); pf[h] = __builtin_bit_cast(bf16x8, pw); }
#pragma unroll
            for (int dt = 0; dt < 2; ++dt) {
                LAS const unsigned char* vp = Vt + (32 * dt + ql) * VP + (32 * kt + 16 * s + 4 * hi) * 2;
                const s16x4 lo = *(LAS const s16x4*)vp; const s16x4 h4 = *(LAS const s16x4*)(vp + 16);
                const bf16x8 vf = (bf16x8){lo[0], lo[1], lo[2], lo[3], h4[0], h4[1], h4[2], h4[3]};
#pragma unroll
                for (int h = 0; h < NH; ++h) Oa[h][dt] = __builtin_amdgcn_mfma_f32_32x32x16_bf16(vf, pf[h], Oa[h][dt], 0, 0, 0);
            }
            if (ONES)
#pragma unroll
                for (int h = 0; h < NH; ++h) Oa[h][ONES ? 2 : 0] = __builtin_amdgcn_mfma_f32_32x32x16_bf16(onesf, pf[h], Oa[h][ONES ? 2 : 0], 0, 0, 0);
        }
        __builtin_amdgcn_sched_barrier(0);
    }
#pragma unroll
    for (int h = 0; h < NH; ++h) {
        float sum = ONES ? Oa[h][ONES ? 2 : 0][0] : vsum[h]; sum += __shfl_xor(sum, 32);
        if (SWA) sum += __builtin_amdgcn_exp2f(sink2[h] - shift2[h]);
        const float inv = 1.0f / sum;
        LAS unsigned char* so = oscr + ql * OS_PITCH + 8 * hi;
#pragma unroll
        for (int dt = 0; dt < 2; ++dt)
#pragma unroll
            for (int rg = 0; rg < 4; ++rg) {
                v2u w; w.x = pk2(Oa[h][dt][4 * rg + 0] * inv, Oa[h][dt][4 * rg + 1] * inv); w.y = pk2(Oa[h][dt][4 * rg + 2] * inv, Oa[h][dt][4 * rg + 3] * inv);
                *(LAS v2u*)(so + 64 * dt + 16 * rg) = w;
            }
        const int rr = lane >> 3, ch = lane & 7;
#pragma unroll
        for (int k = 0; k < 4; ++k) {
            const v4u l = *(const LAS v4u*)(oscr + (8 * k + rr) * OS_PITCH + 16 * ch);
            *(v4u*)(O[h] + (long)(8 * k + rr) * opitch + 8 * ch) = l;
        }
    }
}
constexpr int SWA_VP = 776, MEM_VP = 520;
__device__ __forceinline__ LAS unsigned char* out_stage(LAS unsigned char* lds, int wave) { return lds + ((wave < 5) ? (104960 + wave * OS_BYTES) : (131328 + (wave - 5) * OS_BYTES)); }
constexpr int SWA_VT_OFF = 384 * KP, MEM_VT_OFF = 256 * KP;
}

struct Args { const float* in[19]; float* out; unsigned char* ws; int ph_lo, ph_hi; };

struct MixP { const bf16* PROJ; const bf16* KV; const bf16* MKV; bf16* CAT; const float *knorm, *qnorm, *sinks, *mknorm, *mqnorm; int l; };
__device__ __forceinline__ void unit_load(const MixP& P, int v, int tid, int wave, att::StageRegs& R) {
    asm volatile("" : "+v"(tid));
    const int lane = tid & 63;
    if (v < 512) {
        const int b = v >> 6, rem = v & 63, kvh = rem >> 4, tb = rem & 15; const long t0 = (long)b * SEQ + tb * 256;
        att::stage_load<384>(R, P.KV + (t0 - 128) * 512 + kvh * 64, P.KV + (t0 - 128) * 512 + 256 + kvh * 64, 512, (tb == 0) ? 128 : 0, tid);
    } else {
        const int u = v - 512, b = u >> 5, rem = u & 31, h = rem >> 3, tb = rem & 7; const long t0 = (long)b * SEQ + tb * 512;
        const bf16* ksrc = P.MKV + (long)(b * MEMLEN) * 2048 + P.l * 512 + h * 64;
        att::stage_load<256>(R, ksrc, ksrc + 256, 2048, 0, tid);
    }
}
__device__ __forceinline__ void unit_write(const MixP& P, int v, LAS unsigned char* lds, int tid, const att::StageRegs& R) {
    asm volatile("" : "+v"(tid));
    if (v < 512) att::stage_write<384, att::SWA_VP>(R, lds, lds + att::SWA_VT_OFF, P.knorm, tid);
    else att::stage_write<256, att::MEM_VP>(R, lds, lds + att::MEM_VT_OFF, P.mknorm + P.l * 64, tid);
}
__device__ __forceinline__ void unit_tasks(const MixP& P, int v, LAS unsigned char* lds, int tid, int wave) {
    asm volatile("" : "+v"(tid));
    const int lane = tid & 63;
    if (v < 512) {
        const int j = P.l - NA;
        const int b = v >> 6, rem = v & 63, kvh = rem >> 4, tb = rem & 15; const long t0 = (long)b * SEQ + tb * 256;
        const int i = wave;
        att::QLine qcur; att::q_load_lines(qcur, P.PROJ + (t0 + 32 * i) * 1024 + (kvh * 3) * 64, 1024, lane);
        LAS unsigned char* const stage = att::out_stage(lds, wave);
        f32x4 gv[8]; att::q_gains(P.qnorm + j * 64, lane, gv);
        float sk3[3];
#pragma unroll
        for (int g = 0; g < 3; ++g) sk3[g] = P.sinks[j * 12 + kvh * 3 + g];
        const float bound2 = att::score_bound2(P.qnorm + j * 64, P.knorm, lane);
        LAS unsigned char* Kl = lds; LAS unsigned char* Vt = lds + att::SWA_VT_OFF;
        const int kt_first = (tb == 0) ? ((4 - i) > 0 ? (4 - i) : 0) : 0;
#pragma unroll 1
        for (int g = 0; g < 3; ++g) {
            const int hq = kvh * 3 + g;
            int ln = lane; asm volatile("" : "+v"(ln));
            att::QLine qn = qcur;
            if (g < 2) att::q_load_lines(qn, P.PROJ + (t0 + 32 * i) * 1024 + (hq + 1) * 64, 1024, ln);
            att::QRaw qr; att::q_redistribute(qcur, qr, stage, ln);
            bf16x8 qf[1][4]; att::q_norm(qr, gv, ln, qf[0]);
            const float slope2 = exp2f(-8.0f * (float)(hq + 1) / 12.0f) * LOG2E;
            const float sink2 = ((g == 0) ? sk3[0] : (g == 1) ? sk3[1] : sk3[2]) * LOG2E;
            const float shift2 = fmaxf(bound2, sink2);
            bf16* const O1[1] = {P.CAT + (t0 + 32 * i) * 1024 + hq * 64}; const float sl1[1] = {slope2}, sk1[1] = {sink2}, sh1[1] = {shift2};
            att::task<5, true, att::SWA_VP, 1>(Kl + 32 * i * att::KP, Vt + 32 * i * 2, qf, O1, 1024, sl1, sk1, sh1, kt_first, ln, stage);
            qcur = qn;
        }
    } else {
        const int u = v - 512, b = u >> 5, rem = u & 31, h = rem >> 3, tb = rem & 7; const long t0 = (long)b * SEQ + tb * 512;
        att::QLine ql0, ql1;
        att::q_load_lines(ql0, P.PROJ + (t0 + 32 * wave) * 1024 + MAINW + h * 64, 1024, lane);
        att::q_load_lines(ql1, P.PROJ + (t0 + 32 * (wave + 8)) * 1024 + MAINW + h * 64, 1024, lane);
        LAS unsigned char* const stage = att::out_stage(lds, wave);
        f32x4 gv[8]; att::q_gains(P.mqnorm + P.l * 64, lane, gv);
        const float bound2 = att::score_bound2(P.mqnorm + P.l * 64, P.mknorm + P.l * 64, lane);
        LAS unsigned char* Kl = lds; LAS unsigned char* Vt = lds + att::MEM_VT_OFF;
        int ln = lane; asm volatile("" : "+v"(ln));
        att::QRaw q0, q1; att::q_redistribute(ql0, q0, stage, ln); att::q_redistribute(ql1, q1, stage, ln);
        bf16x8 qf[2][4]; att::q_norm(q0, gv, ln, qf[0]); att::q_norm(q1, gv, ln, qf[1]);
        bf16* const cat = P.CAT + (t0 + 32 * wave) * 1024 + MAINW + h * 64;
        bf16* const O2[2] = {cat, cat + (long)256 * 1024};
        const float z2[2] = {0.f, 0.f}, sh2[2] = {bound2, bound2};
        att::task<8, false, att::MEM_VP, 2>(Kl, Vt, qf, O2, 1024, z2, z2, sh2, 0, ln, stage);
    }
}
template <int W>
__device__ __forceinline__ void pool_run(const bf16* up, bf16* dp, int tin) {
    constexpr int RUN = 32;
    v4u ring[W]; float s[8];
#pragma unroll
    for (int i = 0; i < 8; ++i) s[i] = 0.f;
#pragma unroll
    for (int k = 0; k < W; ++k) { ring[k] = (v4u){0u, 0u, 0u, 0u}; if (tin > 0) ring[k] = *(const v4u*)(up - (long)(W - k) * 1024); }
#pragma unroll
    for (int k = 0; k < W; ++k) { float f[8]; unpack8(ring[k], f);
#pragma unroll
        for (int i = 0; i < 8; ++i) s[i] += f[i]; }
#pragma unroll
    for (int tb = 0; tb < RUN; tb += 8) {
        v4u xr[8];
#pragma unroll
        for (int j = 0; j < 8; ++j) xr[j] = *(const v4u*)(up + (long)(tb + j) * 1024);
#pragma unroll
        for (int j = 0; j < 8; ++j) {
            const int t = tb + j;
            float x[8], p[8]; unpack8(xr[j], x); unpack8(ring[t % W], p);
            ring[t % W] = xr[j];
            const float rc = (tin > 0 || t + 1 >= W) ? (1.0f / (float)W) : (1.0f / (float)(t + 1));
            float d[8];
#pragma unroll
            for (int i = 0; i < 8; ++i) { s[i] += x[i] - p[i]; d[i] = s[i] * rc - x[i]; }
            *(v4u*)(dp + (long)t * 1024) = pack8(d);
        }
        asm volatile("" ::: "memory");
    }
}
__device__ __forceinline__ void pool_pass(const bf16* PROJ, bf16* DOUT, int bx, int G, int wave, int lane) {
    if (wave >= 6) return;
    for (int wi = bx * 6 + wave; wi < 4 * 3 * 128; wi += G * 6) {
        const int g = wi / 384, rem = wi - g * 384, cb = rem >> 7, rb = rem & 127;
        const int run = rb * 8 + (lane >> 3), c = g * 24 + cb * 8 + (lane & 7);
        const long t0 = (long)run * 32; const int tin = (int)(t0 & (SEQ - 1));
        const bf16* up = PROJ + t0 * 1024 + 8 * c; bf16* dp = DOUT + t0 * 1024 + 8 * c;
        if (g == 0) pool_run<2>(up, dp, tin); else if (g == 1) pool_run<4>(up, dp, tin); else if (g == 2) pool_run<8>(up, dp, tin); else pool_run<16>(up, dp, tin);
    }
}

enum { I_X = 0, I_MEM, I_NORM_MIX, I_W_IN, I_POOL_W, I_POOL_SCALE, I_KV_NORM, I_W_KV, I_K_NORM, I_Q_NORM, I_SINKS, I_MEM_NORM, I_W_MEM_KV,
       I_MEM_Q_NORM, I_MEM_K_NORM, I_W_OUT, I_NORM_MLP, I_W_UP, I_W_DOWN };

constexpr int NTR = 2048 + 2048 + 8192 + 8192 + 1024 + 256;
constexpr size_t WS_TMPA = WS_BIG + 128 * MiB, WS_PP = WS_BIG + 136 * MiB;
struct TrD { const float* W; bf16* WT; const float* gk; int ldw, ldt; };
__device__ __forceinline__ void tr_load(const TrD& d, f32x4 (&v)[8], int lane) {
#pragma unroll
    for (int i = 0; i < 8; ++i) v[i] = *(const f32x4*)(d.W + (size_t)(8 * i + (lane >> 3)) * d.ldw + 4 * (lane & 7));
}
__device__ __forceinline__ void tr_store(const TrD& d, const f32x4 (&v)[8], LAS float* scr, int lane) {
#pragma unroll
    for (int i = 0; i < 8; ++i) { LAS float* p = scr + (8 * i + (lane >> 3)) * 33 + 4 * (lane & 7); p[0] = v[i][0]; p[1] = v[i][1]; p[2] = v[i][2]; p[3] = v[i][3]; }
    LDS_WAIT(); asm volatile("" ::: "memory");
    const int c = lane & 7;
    f32x4 g0 = (f32x4){1.f, 1.f, 1.f, 1.f}, g1 = g0;
    if (d.gk) { g0 = *(const f32x4*)(d.gk + 8 * c); g1 = *(const f32x4*)(d.gk + 8 * c + 4); }
#pragma unroll
    for (int j = 0; j < 4; ++j) { const int n = (lane >> 3) + 8 * j; const LAS float* s = scr + (8 * c) * 33 + n;
        v4u o; o.x = pk2(s[0 * 33] * g0[0], s[1 * 33] * g0[1]); o.y = pk2(s[2 * 33] * g0[2], s[3 * 33] * g0[3]); o.z = pk2(s[4 * 33] * g1[0], s[5 * 33] * g1[1]); o.w = pk2(s[6 * 33] * g1[2], s[7 * 33] * g1[3]);
        *(v4u*)(d.WT + (size_t)n * d.ldt + 8 * c) = o; }
    LDS_WAIT(); asm volatile("" ::: "memory");
}
__device__ __forceinline__ void rms_row(const float* xrow, bf16* orow, int lane) {
    const f32x4* xr = (const f32x4*)xrow + lane;
    f32x4 v[4]; float s = 0.f;
#pragma unroll
    for (int j = 0; j < 4; ++j) { v[j] = xr[64 * j]; s += (v[j].x * v[j].x + v[j].y * v[j].y) + (v[j].z * v[j].z + v[j].w * v[j].w); }
    const float rstd = 1.0f / sqrtf(wave_sum(s) * (1.0f / DM) + EPS);
    unsigned long long* o8 = (unsigned long long*)orow + lane;
#pragma unroll
    for (int j = 0; j < 4; ++j) o8[64 * j] = (unsigned long long)pk2(v[j].x * rstd, v[j].y * rstd) | ((unsigned long long)pk2(v[j].z * rstd, v[j].w * rstd) << 32);
}
struct XRows { f32x4 v[2][4]; };
__device__ __forceinline__ void xrows_load(XRows& x, const float* x0, const float* x1, int lane) {
    const f32x4* pa = (const f32x4*)x0 + 2 * lane; const f32x4* pb = (const f32x4*)x1 + 2 * lane;
#pragma unroll
    for (int j = 0; j < 2; ++j) { x.v[0][2 * j] = pa[128 * j]; x.v[0][2 * j + 1] = pa[128 * j + 1]; x.v[1][2 * j] = pb[128 * j]; x.v[1][2 * j + 1] = pb[128 * j + 1]; }
}
__device__ __forceinline__ void xrows_store(const XRows& x, bf16* o0, bf16* o1, float* q0, float* q1, int lane) {
    float ss[2];
#pragma unroll
    for (int r = 0; r < 2; ++r) {
        v4u* op = (v4u*)(r == 0 ? o0 : o1) + lane; float s = 0.f;
#pragma unroll
        for (int j = 0; j < 2; ++j) {
            const f32x4 a = x.v[r][2 * j], b = x.v[r][2 * j + 1];
            v4u w; w.x = pk2(a.x, a.y); w.y = pk2(a.z, a.w); w.z = pk2(b.x, b.y); w.w = pk2(b.z, b.w);
            const float r0 = bf_lo(w.x), r1 = bf_hi(w.x), r2 = bf_lo(w.y), r3 = bf_hi(w.y), r4 = bf_lo(w.z), r5 = bf_hi(w.z), r6 = bf_lo(w.w), r7 = bf_hi(w.w);
            s += ((r0 * r0 + r1 * r1) + (r2 * r2 + r3 * r3)) + ((r4 * r4 + r5 * r5) + (r6 * r6 + r7 * r7));
            op[64 * j] = w;
        }
        ss[r] = wave_sum(s);
    }
    if (lane < 16) { q0[lane] = (lane == 0) ? ss[0] : 0.f; q1[lane] = (lane == 0) ? ss[1] : 0.f; }
}
__device__ __forceinline__ void fold_item(const float* P, const float* scale, const float* Wo, bf16* WT, int item, int lane) {
    const int c0 = (item >> 4) * 8, n = (item & 15) * 64 + lane;
    float acc[8];
#pragma unroll
    for (int j = 0; j < 8; ++j) acc[j] = 0.f;
    for (int d = 0; d < 192; d += 4) {
        const f32x4 sc = *(const f32x4*)(scale + d);
        float w[4];
#pragma unroll
        for (int e = 0; e < 4; ++e) w[e] = Wo[(size_t)(d + e) * DM + n] * sc[e];
#pragma unroll
        for (int j = 0; j < 8; ++j) { const f32x4 p = *(const f32x4*)(P + (c0 + j) * 192 + d); acc[j] += (p[0] * w[0] + p[1] * w[1]) + (p[2] * w[2] + p[3] * w[3]); }
    }
    *(v4u*)(WT + (size_t)n * DM + c0) = pack8(acc);
}

__device__ __forceinline__ void tr_decode(const Args& a, unsigned char* ws, int r, TrD& d) {
    const float* W; bf16* WT; const float* gk = nullptr; int ldw, ldt, nblk, item;
    if (r < 2048) { const int l = r >> 9; item = r & 511; W = a.in[I_W_IN] + (size_t)l * DM * DM; ldw = DM; WT = (bf16*)(ws + WS_WIN + l * 3 * MiB); ldt = DM; nblk = 32; gk = a.in[I_NORM_MIX] + l * DM; }
    else if ((r -= 2048) < 2048) { const int l = r >> 9; item = r & 511;
        W = a.in[I_W_OUT] + (size_t)l * DM * DM; ldw = DM; WT = (bf16*)(ws + WS_WOUT + l * 2 * MiB); ldt = DM; nblk = 32;
        if (l < NA && item < 12 * 32) { WT = (bf16*)(ws + WS_TMPA + l * 2 * MiB); ldt = MAINW; } }
    else if ((r -= 2048) < 8192) { const int l = r >> 11; item = r & 2047; W = a.in[I_W_UP] + (size_t)l * DM * DFF; ldw = DFF; WT = (bf16*)(ws + WS_WUP + l * 8 * MiB); ldt = DM; nblk = 128; gk = a.in[I_NORM_MLP] + l * DM; }
    else if ((r -= 8192) < 8192) { const int l = r >> 11; item = r & 2047; W = a.in[I_W_DOWN] + (size_t)l * DFF * DM; ldw = DM; WT = (bf16*)(ws + WS_WDN + l * 8 * MiB); ldt = DFF; nblk = 32; }
    else if ((r -= 8192) < 1024) { const int l = r >> 8; item = r & 255; W = a.in[I_W_MEM_KV] + (size_t)l * DM * 512; ldw = 512; WT = (bf16*)(ws + WS_WMKV) + (size_t)l * 512 * DM; ldt = DM; nblk = 16; gk = a.in[I_MEM_NORM] + l * DM; }
    else { r -= 1024; item = r; W = a.in[I_W_KV]; ldw = 512; WT = (bf16*)(ws + WS_WIN + 2 * 3 * MiB) + (size_t)1024 * DM; ldt = DM; nblk = 16; gk = a.in[I_KV_NORM]; }
    const int kb = item / nblk, nb = item - kb * nblk, k0 = 64 * kb, n0 = 32 * nb;
    d.W = W + (size_t)k0 * ldw + n0; d.WT = WT + (size_t)n0 * ldt + k0; d.gk = gk ? gk + k0 : nullptr; d.ldw = ldw; d.ldt = ldt;
}
__device__ __forceinline__ void prologue(const Args& a, unsigned char* ws, LAS unsigned char* lds, int gw, int NGW, int lane, int wave) {
    LAS float* scr = (LAS float*)(lds + wave * 16384);
    {
        int it = gw; TrD dc; f32x4 vc[8];
        bool hc = it < NTR;
        if (hc) { tr_decode(a, ws, it, dc); tr_load(dc, vc, lane); }
        while (hc) {
            const int itn = it + NGW; const bool hn = itn < NTR;
            TrD dn = dc; f32x4 vn[8];
#pragma unroll
            for (int i = 0; i < 8; ++i) vn[i] = vc[i];
            if (hn) { tr_decode(a, ws, itn, dn); tr_load(dn, vn, lane); }
            tr_store(dc, vc, scr, lane);
            dc = dn;
#pragma unroll
            for (int i = 0; i < 8; ++i) vc[i] = vn[i];
            hc = hn; it = itn;
        }
    }
    for (int it = gw * 64 + lane; it < 2 * MAINW * (MAINW / 8); it += NGW * 64) {
        const int l = it / (MAINW * (MAINW / 8)), r = it - l * (MAINW * (MAINW / 8)), c = r / (MAINW / 8), ch = r - c * (MAINW / 8), g = c / 192;
        v4u o = (v4u){0u, 0u, 0u, 0u};
        if (ch / 24 == g) { const float* p = a.in[I_POOL_W] + ((size_t)(l * 4 + g) * 192 + (c - g * 192)) * 192 + (8 * ch - g * 192); const float* sc = a.in[I_POOL_SCALE] + l * MAINW + 8 * ch;
            const f32x4 p0 = *(const f32x4*)p, p1 = *(const f32x4*)(p + 4), s0 = *(const f32x4*)sc, s1 = *(const f32x4*)(sc + 4);
            o.x = pk2(p0[0] * s0[0], p0[1] * s0[1]); o.y = pk2(p0[2] * s0[2], p0[3] * s0[3]); o.z = pk2(p1[0] * s1[0], p1[1] * s1[1]); o.w = pk2(p1[2] * s1[2], p1[3] * s1[3]); }
        *(v4u*)((bf16*)(ws + WS_PP + l * 2 * MiB) + (size_t)c * MAINW + 8 * ch) = o;
    }
    for (int m = gw; m < MROWS; m += NGW) rms_row(a.in[I_MEM] + (size_t)m * DM, (bf16*)(ws + WS_MEMN) + (size_t)m * DM, lane);
    {
        int m = gw; XRows xc;
        if (m < M) xrows_load(xc, a.in[I_X] + (size_t)m * DM, a.in[I_X] + (size_t)(m + NGW) * DM, lane);
        while (m < M) {
            const int mn = m + 2 * NGW; XRows xn = xc;
            if (mn < M) xrows_load(xn, a.in[I_X] + (size_t)mn * DM, a.in[I_X] + (size_t)(mn + NGW) * DM, lane);
            xrows_store(xc, (bf16*)(ws + WS_XN) + (size_t)m * DM, (bf16*)(ws + WS_XN) + (size_t)(m + NGW) * DM,
                        (float*)(ws + WS_SSQ + 2 * MiB) + (size_t)m * 16, (float*)(ws + WS_SSQ + 2 * MiB) + (size_t)(m + NGW) * 16, lane);
            xc = xn; m = mn;
        }
    }
}

enum { K_PRO = 0, K_INPROJ, K_MIX, K_OUT, K_UP, K_DOWN };
constexpr int NPHASES = 21;
__device__ __forceinline__ void decode_phase(int ph, int& kind, int& l) {
    if (ph == 0) { kind = K_PRO; l = 0; return; }
    const int p = ph - 1; l = p / 5; const int k = p - 5 * l;
    kind = (k == 0) ? K_INPROJ : (k == 1) ? K_MIX : (k == 2) ? K_OUT : (k == 3) ? K_UP : K_DOWN;
}

__global__ void __launch_bounds__(NTHR, 2) fwd_kernel(Args a) {
    extern __shared__ __attribute__((aligned(16))) unsigned char lds_raw[];
    LAS unsigned char* lds = (LAS unsigned char*)lds_raw;
    volatile LAS unsigned* MISC = (volatile LAS unsigned*)(lds + MISC_OFF);
    if (threadIdx.x < 64) MISC[threadIdx.x] = 0u;
    __syncthreads();
    const int lo = a.ph_lo, hi = a.ph_hi;
    XcdBarrier bar; bar.bar = (unsigned*)(a.ws + WS_CTL); bar.x = 0; bar.st = nullptr;
    if (hi - lo > 1) bar = xcd_barrier_post((unsigned*)(a.ws + WS_CTL), MISC + 8);
    if (lo < 0) { cg::this_grid().sync(); }

    for (int ph = lo; ph < hi; ++ph) {
        int tid = threadIdx.x, bx = blockIdx.x, G = gridDim.x; unsigned long long zo = 0;
        asm volatile("" : "+v"(tid)); asm volatile("" : "+s"(bx), "+s"(G)); asm volatile("" : "+s"(zo));
        unsigned char* ws = a.ws + zo; float* outp = (float*)((unsigned char*)a.out + zo);
        const int lane = tid & 63, wave = __builtin_amdgcn_readfirstlane(tid >> 6);
        const int gw = bx * NWAVES + wave, NGW = G * NWAVES, gthread = bx * NTHR + tid, nthreads = G * NTHR;
        bf16* const XN = (bf16*)(ws + WS_XN);
        bf16* const PROJ = (bf16*)(ws + WS_BIG);
        bf16* const CAT = (bf16*)(ws + WS_BIG + 64 * MiB);
        bf16* const HID = (bf16*)(ws + WS_BIG);
        bf16* const KV = (bf16*)(ws + WS_KV);
        bf16* const MKV = (bf16*)(ws + WS_MKV);
        int kind, l; decode_phase(ph, kind, l);
        float* const SSQ0 = (float*)(ws + WS_SSQ);
        float* const SSQ1 = (float*)(ws + WS_SSQ + 2 * MiB);
        if (kind == K_PRO) {
            prologue(a, ws, lds, gw, NGW, lane, wave);
        } else if (kind == K_MIX) {
            MixP P; P.PROJ = PROJ; P.KV = KV; P.MKV = MKV; P.CAT = CAT; P.knorm = a.in[I_K_NORM]; P.qnorm = a.in[I_Q_NORM]; P.sinks = a.in[I_SINKS];
            P.mknorm = a.in[I_MEM_K_NORM]; P.mqnorm = a.in[I_MEM_Q_NORM]; P.l = l;
            att::StageRegs R;
            int v = (l < NA) ? 512 + bx : bx;
            if (l < NA) pool_pass(PROJ, CAT, bx, G, wave, lane);
            unit_load(P, v, tid, wave, R);
            while (v < 768) {
                unit_write(P, v, lds, tid, R);
                LDS_WAIT(); __syncthreads();
                const int vn = v + G;
                if (v < 512) { if (vn < 768) unit_load(P, vn, tid, wave, R); unit_tasks(P, v, lds, tid, wave); }
                else { unit_tasks(P, v, lds, tid, wave); if (vn < 768) unit_load(P, vn, tid, wave, R); }
                __syncthreads();
                v = vn;
            }
        } else {
            const int ng = (kind == K_INPROJ && l == 0) ? 4 : 1;
            for (int gi = 0; gi < ng; ++gi) {
                pg8::Gemm g; pg8::EpiB E; E.O2 = KV; E.ldc2 = 512; E.split_pn = 1 << 30; E.mode = 0; E.ssq_in = nullptr; E.ssq_out = SSQ0; E.outf = outp; E.scr = lds + EPI_SCR_OFF; g.M = M; g.K = DM;
                int cb = bx;
                if (kind == K_INPROJ && ng == 4 && gi == 0) { g.A = (const bf16*)(ws + WS_MEMN); g.Bt = (const bf16*)(ws + WS_WMKV); g.M = MROWS; g.N = 2048; E.O1 = MKV; E.ldc1 = 2048; }
                else if (kind == K_INPROJ && ng == 4 && gi < 3) {
                    const int fl = gi - 1; g.A = (const bf16*)(ws + WS_TMPA + fl * 2 * MiB); g.Bt = (const bf16*)(ws + WS_PP + fl * 2 * MiB); g.M = DM; g.N = MAINW; g.K = MAINW;
                    E.O1 = (bf16*)(ws + WS_WOUT + fl * 2 * MiB); E.ldc1 = DM; cb = (bx + G - 64 - 12 * fl) % G; }
                else if (kind == K_INPROJ) { g.A = XN; g.Bt = (const bf16*)(ws + WS_WIN + l * 3 * MiB); g.N = (l == 2) ? 1536 : 1024; E.O1 = PROJ; E.ldc1 = 1024; E.split_pn = 4; E.ssq_in = SSQ1; }
                else if (kind == K_OUT) { g.A = CAT; g.Bt = (const bf16*)(ws + WS_WOUT + l * 2 * MiB); g.N = DM; E.O1 = XN; E.ldc1 = DM; E.mode = 2; }
                else if (kind == K_UP) { g.A = XN; g.Bt = (const bf16*)(ws + WS_WUP + l * 8 * MiB); g.N = DFF; E.O1 = HID; E.ldc1 = DFF; E.mode = 1; }
                else { g.A = HID; g.Bt = (const bf16*)(ws + WS_WDN + l * 8 * MiB); g.N = DM; g.K = DFF; E.O1 = XN; E.ldc1 = DM; E.mode = (l == DEPTH - 1) ? 3 : 2; E.ssq_in = SSQ0; E.ssq_out = SSQ1; }
                pg8::StaticOrder S; S.init(g.M, g.N, G, cb);
                pg8::gemm_phase<pg8::EpiB, pg8::StaticOrder, true, true>(lds, g, S, E);
            }
        }
        if (ph + 1 < hi) { bar.bar = (unsigned*)(ws + WS_CTL); xcd_barrier(bar); }
    }
}

#ifndef PER_PHASE_LAUNCH
#define PER_PHASE_LAUNCH 0
#endif
extern "C" void kernel_launch(void* const* d_in, const int* in_sizes, int n_in, void* d_out, int out_size, void* d_ws, size_t ws_size, hipStream_t stream) {
    static int grid = 0;
    if (grid == 0) {
        if (n_in != 19 || out_size != M * DM || ws_size < WS_END) { fprintf(stderr, "kernel_launch: unexpected shapes (n_in %d out %d ws %zu)\n", n_in, out_size, ws_size); grid = -1; return; }
        int dev = 0, cus = 0, per_cu = 0;
        if (hipGetDevice(&dev) != hipSuccess || hipDeviceGetAttribute(&cus, hipDeviceAttributeMultiprocessorCount, dev) != hipSuccess) { grid = -1; return; }
        if (hipFuncSetAttribute((const void*)fwd_kernel, hipFuncAttributeMaxDynamicSharedMemorySize, LDS_BYTES) != hipSuccess) { fprintf(stderr, "kernel_launch: hipFuncSetAttribute failed\n"); grid = -1; return; }
        if (hipOccupancyMaxActiveBlocksPerMultiprocessor(&per_cu, (const void*)fwd_kernel, NTHR, LDS_BYTES) != hipSuccess || per_cu < 1) { fprintf(stderr, "kernel_launch: occupancy query says %d\n", per_cu); per_cu = 1; }
        (void)hipGetLastError();
        grid = cus < 256 ? cus : 256;
    }
    if (grid < 0) return;
    (void)hipMemsetAsync((char*)d_ws + WS_CTL, 0, CTL_BYTES, stream);
    Args a{};
    for (int i = 0; i < 19; ++i) a.in[i] = (const float*)d_in[i];
    a.out = (float*)d_out; a.ws = (unsigned char*)d_ws;
#if PER_PHASE_LAUNCH
    for (int ph = 0; ph < NPHASES; ++ph) {
        a.ph_lo = ph; a.ph_hi = ph + 1;
        hipLaunchKernelGGL(fwd_kernel, dim3(grid), dim3(NTHR), LDS_BYTES, stream, a);
    }
#else
    a.ph_lo = 0; a.ph_hi = NPHASES;
    void* params[] = {&a};
    hipError_t e = hipLaunchCooperativeKernel((const void*)fwd_kernel, dim3(grid), dim3(NTHR), params, LDS_BYTES, stream);
    if (e != hipSuccess) fprintf(stderr, "cooperative launch failed: %s (grid %d)\n", hipGetErrorString(e), grid);
#endif
}
```

```cpp
#include <hip/hip_runtime.h>
#include <hip/hip_cooperative_groups.h>
#include <cstdio>
#include <cstdint>
namespace cg = cooperative_groups;
namespace pg8 {
#define PG8_LAS __attribute__((address_space(3)))
typedef unsigned short bf16_t;
typedef short bf16x8 __attribute__((ext_vector_type(8)));
typedef float f32x4 __attribute__((ext_vector_type(4)));
typedef unsigned u32x4 __attribute__((ext_vector_type(4)));
constexpr int BM = 256, BK = 64, HALF = 128, HTB = HALF * BK * 2  , STAGE_BYTES = 8 * HTB, NXCD = 8, WGM = 8;

__host__ __device__ __forceinline__ int lds_byte(int r, int c) { const int st = (r >> 4) * 2 + (c >> 5), rr = r & 15, cc = c & 31, ob = rr * 64 + cc * 2; return st * 1024 + (ob ^ (((ob >> 9) & 1) << 5)); }
__host__ __device__ __forceinline__ void stage_rc(int b, int& R, int& C) { const int st = b / 1024, sb = b % 1024, swz = sb ^ (((sb >> 9) & 1) << 5); R = (st >> 1) * 16 + swz / 64; C = (st & 1) * 32 + (swz % 64) / 2; }
__host__ __device__ __forceinline__ int perm32(int rho) { const int n = rho >> 4, i = rho & 15; return 8 * (i >> 2) + 4 * n + (i & 3); }

struct Unit { int pm, pn; };
struct Gemm { const bf16_t* A; const bf16_t* Bt; int M, N, K; };

struct StaticOrder {
    int nM, nN, nwg, G, c;
    __host__ __device__ void init(int M, int N, int G_, int c_) { nM = M / BM; nN = N / BM; nwg = nM * nN; G = G_; c = c_; }
    __host__ __device__ bool next(int i, Unit& u) const {
        const long L = (long)i * G + c; if (L >= nwg) return false;
        int wgid = (int)L; { const int q = nwg / NXCD, r = nwg % NXCD, xcd = wgid % NXCD, off = wgid / NXCD; wgid = (xcd < r ? xcd * (q + 1) : r * (q + 1) + (xcd - r) * q) + off; }
        const int nig = WGM * nN, gid = wgid / nig, fm = gid * WGM, gsz = (nM - fm) < WGM ? (nM - fm) : WGM;
        u.pm = fm + ((wgid % nig) % gsz); u.pn = (wgid % nig) / gsz; return true;
    }
    __device__ __forceinline__ void a_ready(const Unit&) const {}
    __device__ __forceinline__ void done(const Unit&) const {}
};

typedef float f32x2 __attribute__((ext_vector_type(2)));
typedef __bf16 bf16x2_t __attribute__((ext_vector_type(2)));
__device__ __forceinline__ unsigned cvt_pk_bf16(float lo, float hi) { f32x2 v = {lo, hi}; bf16x2_t b = __builtin_convertvector(v, bf16x2_t); return __builtin_bit_cast(unsigned, b); }
__device__ __forceinline__ float bflo(unsigned u) { return __builtin_bit_cast(float, u << 16); }
__device__ __forceinline__ float bfhi(unsigned u) { return __builtin_bit_cast(float, u & 0xffff0000u); }

#ifndef EPI_ST
#define EPI_ST 0
#endif
__device__ __forceinline__ void st16(void* p, u32x4 v) {
#if EPI_ST == 1
    asm volatile("global_store_dwordx4 %0, %1, off sc1\n\ts_nop 1" :: "v"(p), "v"(v) : "memory");
#elif EPI_ST == 2
    __builtin_nontemporal_store(v, (u32x4*)p);
#else
    *(u32x4*)p = v;
#endif
}
__device__ __forceinline__ float relu_f(float x) { float y; asm("v_max_f32_e32 %0, 0, %1" : "=v"(y) : "v"(x)); return y; }
struct EpiB {
    static constexpr bool PERM = true, AFTER_DRAIN = false, WIDE = true;
    static constexpr int SCR_PITCH = 144, SCR_BYTES = 16 * SCR_PITCH;
    bf16_t* O1; int ldc1; bf16_t* O2; int ldc2; int split_pn; int mode; const float* ssq_in; float* ssq_out; float* outf; PG8_LAS unsigned char* scr;
    template <int MODE>
    __device__ __forceinline__ void body(const f32x4 (&acc)[2][2][4][2], bf16_t* base, int ldc, int rowt, int colw, const float (&rs)[2][4], int pn, int wr, int wc, int fr, int fq) const {
        const int col0 = colw + 8 * fq;
        if (MODE == 3) {
            PG8_LAS unsigned char* wscr3 = scr + (wr * 4 + wc) * SCR_BYTES;
            const int lane3 = fr + 16 * fq, rr3 = lane3 >> 3, ch3 = lane3 & 7;
#pragma unroll
            for (int ai = 0; ai < 2; ++ai)
#pragma unroll
                for (int m = 0; m < 4; ++m) {
                    const int rowg = rowt + ai * HALF + wr * 64 + m * 16;
                    const u32x4 hl0 = *(const u32x4*)(base + (size_t)(rowg + rr3) * ldc + colw + 8 * ch3), hl1 = *(const u32x4*)(base + (size_t)(rowg + 8 + rr3) * ldc + colw + 8 * ch3);
                    *(PG8_LAS u32x4*)(wscr3 + rr3 * SCR_PITCH + ch3 * 16) = hl0; *(PG8_LAS u32x4*)(wscr3 + (rr3 + 8) * SCR_PITCH + ch3 * 16) = hl1;
                    u32x4 hb[2]; hb[0] = *(const PG8_LAS u32x4*)(wscr3 + fr * SCR_PITCH + fq * 16); hb[1] = *(const PG8_LAS u32x4*)(wscr3 + fr * SCR_PITCH + fq * 16 + 64);
#pragma unroll
                    for (int bj = 0; bj < 2; ++bj) {
                        const u32x4 h = hb[bj];
                        f32x4 v0 = acc[ai][bj][m][0] * rs[ai][m], v1 = acc[ai][bj][m][1] * rs[ai][m];
                        v0[0] += bflo(h.x); v0[1] += bfhi(h.x); v0[2] += bflo(h.y); v0[3] += bfhi(h.y);
                        v1[0] += bflo(h.z); v1[1] += bfhi(h.z); v1[2] += bflo(h.w); v1[3] += bfhi(h.w);
                        *(PG8_LAS f32x4*)(wscr3 + fr * SCR_PITCH + fq * 32) = v0; *(PG8_LAS f32x4*)(wscr3 + fr * SCR_PITCH + fq * 32 + 16) = v1;
                        const f32x4 o0 = *(const PG8_LAS f32x4*)(wscr3 + rr3 * SCR_PITCH + ch3 * 16), o1 = *(const PG8_LAS f32x4*)(wscr3 + (rr3 + 8) * SCR_PITCH + ch3 * 16);
                        float* op = outf + (size_t)(rowg + rr3) * ldc + colw + 32 * bj + 4 * ch3;
                        *(f32x4*)op = o0; *(f32x4*)(op + (size_t)8 * ldc) = o1;
                    }
                }
            return;
        }
        PG8_LAS unsigned char* wscr = scr + (wr * 4 + wc) * SCR_BYTES;
        PG8_LAS unsigned char* wp = wscr + fr * SCR_PITCH + fq * 16;
        const int lane = fr + 16 * fq, rr = lane >> 3, ch = lane & 7;
        const PG8_LAS unsigned char* rp = wscr + rr * SCR_PITCH + ch * 16;
#pragma unroll
        for (int ai = 0; ai < 2; ++ai) {
            u32x4 hl[4][2];
            if (MODE == 2) {
#pragma unroll
                for (int m = 0; m < 4; ++m)
#pragma unroll
                    for (int k = 0; k < 2; ++k) hl[m][k] = *(const u32x4*)(base + (size_t)(rowt + ai * HALF + wr * 64 + m * 16 + 8 * k + rr) * ldc + colw + 8 * ch);
            }
#pragma unroll
            for (int m = 0; m < 4; ++m) {
                const int rowg = rowt + ai * HALF + wr * 64 + m * 16;
                float ss = 0.f;
                u32x4 hb[2];
                if (MODE == 2) {
                    *(PG8_LAS u32x4*)(wscr + rr * SCR_PITCH + ch * 16) = hl[m][0]; *(PG8_LAS u32x4*)(wscr + (rr + 8) * SCR_PITCH + ch * 16) = hl[m][1];
                    hb[0] = *(const PG8_LAS u32x4*)wp; hb[1] = *(const PG8_LAS u32x4*)(wp + 64);
                }
#pragma unroll
                for (int bj = 0; bj < 2; ++bj) {
                    f32x4 v0 = acc[ai][bj][m][0], v1 = acc[ai][bj][m][1];
                    if (MODE == 0) { v0 = v0 * rs[ai][m]; v1 = v1 * rs[ai][m]; }
                    else if (MODE == 1) {
#pragma unroll
                        for (int e = 0; e < 4; ++e) { const float x = relu_f(v0[e]); v0[e] = x * x; const float y = relu_f(v1[e]); v1[e] = y * y; } }
                    else { const u32x4 h = hb[bj]; v0 = v0 * rs[ai][m]; v1 = v1 * rs[ai][m];
                        v0[0] += bflo(h.x); v0[1] += bfhi(h.x); v0[2] += bflo(h.y); v0[3] += bfhi(h.y);
                        v1[0] += bflo(h.z); v1[1] += bfhi(h.z); v1[2] += bflo(h.w); v1[3] += bfhi(h.w); }
                    u32x4 w; w.x = cvt_pk_bf16(v0[0], v0[1]); w.y = cvt_pk_bf16(v0[2], v0[3]); w.z = cvt_pk_bf16(v1[0], v1[1]); w.w = cvt_pk_bf16(v1[2], v1[3]);
                    if (MODE == 2) { const float r0 = bflo(w.x), r1 = bfhi(w.x), r2 = bflo(w.y), r3 = bfhi(w.y), r4 = bflo(w.z), r5 = bfhi(w.z), r6 = bflo(w.w), r7 = bfhi(w.w);
                        ss += ((r0 * r0 + r1 * r1) + (r2 * r2 + r3 * r3)) + ((r4 * r4 + r5 * r5) + (r6 * r6 + r7 * r7)); }
                    *(PG8_LAS u32x4*)(wp + 64 * bj) = w;
                }
                const u32x4 l0 = *(const PG8_LAS u32x4*)rp, l1 = *(const PG8_LAS u32x4*)(rp + 8 * SCR_PITCH);
                bf16_t* gp = base + (size_t)(rowg + rr) * ldc + colw + 8 * ch;
                st16(gp, l0); st16(gp + (size_t)8 * ldc, l1);
                if (MODE == 2) {
                    ss += __shfl_xor(ss, 16); ss += __shfl_xor(ss, 32);
                    if (fq == 0) ssq_out[(size_t)(rowg + fr) * 16 + pn * 4 + wc] = ss;
                }
            }
        }
    }
    __device__ __forceinline__ void operator()(const f32x4 (&acc)[2][2][4][2], const Unit& u, int wr, int wc, int fr, int fq) const {
        const int row0 = u.pm * BM + wr * 64 + fr;
        bf16_t* base = O1; int ldc = ldc1; int colt = u.pn * BM;
        if (u.pn >= split_pn) { base = O2; ldc = ldc2; colt = (u.pn - split_pn) * BM; }
        const int colw = colt + wc * 64;
        float rs[2][4];
        if (ssq_in) {
            const int lane = fr + 16 * fq, rq = lane >> 2, cq = lane & 3;
            f32x4 q[2][4];
#pragma unroll
            for (int ai = 0; ai < 2; ++ai)
#pragma unroll
                for (int m = 0; m < 4; ++m) q[ai][m] = *(const f32x4*)(ssq_in + (size_t)(u.pm * BM + ai * HALF + wr * 64 + m * 16 + rq) * 16 + 4 * cq);
#pragma unroll
            for (int ai = 0; ai < 2; ++ai)
#pragma unroll
                for (int m = 0; m < 4; ++m) { float t = (q[ai][m][0] + q[ai][m][1]) + (q[ai][m][2] + q[ai][m][3]); t += __shfl_xor(t, 1); t += __shfl_xor(t, 2);
                    const float tr = __shfl(t, 4 * fr);
                    const float r = __builtin_amdgcn_rsqf(tr * (1.0f / 1024.0f) + 1e-6f); rs[ai][m] = (mode >= 2) ? r * r : r; }
        } else {
#pragma unroll
            for (int ai = 0; ai < 2; ++ai)
#pragma unroll
                for (int m = 0; m < 4; ++m) rs[ai][m] = 1.0f;
        }
        const int rowt = u.pm * BM;
        if (mode == 1) body<1>(acc, base, ldc, rowt, colw, rs, u.pn, wr, wc, fr, fq);
        else if (mode == 0) body<0>(acc, base, ldc, rowt, colw, rs, u.pn, wr, wc, fr, fq);
        else if (mode == 2) body<2>(acc, base, ldc, rowt, colw, rs, u.pn, wr, wc, fr, fq);
        else body<3>(acc, base, ldc, rowt, colw, rs, u.pn, wr, wc, fr, fq);
    }
};

template <class Epi, class Sched, bool ALIGN_EPI = false, bool SP2 = false>
__device__ __forceinline__ void gemm_phase(PG8_LAS unsigned char* lds, const Gemm g, const Sched& S, const Epi& E) {
    int tid_ = threadIdx.x; asm volatile("" : "+v"(tid_));
    const int tid = tid_, wid = __builtin_amdgcn_readfirstlane(tid >> 6), lane = tid & 63, wr = wid >> 2, wc = wid & 3, fr = lane & 15, fq = lane >> 4;
    const int K = g.K, nt = K / BK;
    unsigned voffA[2], voffB[2];
#pragma unroll
    for (int i = 0; i < 2; ++i) { int R, C; stage_rc(tid * 16 + i * 8192, R, C); const int Rb = Epi::PERM ? (Epi::WIDE ? (64 * (R >> 5) + perm32(R & 31)) : ((R & ~31) + perm32(R & 31))) : R;
        voffA[i] = (unsigned)(R * K + C) * 2u; voffB[i] = (unsigned)(Rb * K + C) * 2u; }
    const size_t kstep = (size_t)(BK * 2);
    const size_t hstep = (size_t)HALF * K * 2;
    const size_t tstep = 2 * hstep;
    const size_t hstepB = (Epi::PERM && Epi::WIDE) ? (size_t)32 * K * 2 : hstep;
    const unsigned ldsw = (unsigned)wid * 1024u;
    const int aoff = lds_byte(wr * 64 + fr, fq * 8), boff = lds_byte(wc * 32 + fr, fq * 8);
#define PG8_SA(b, h) (((b) * 2 + (h)) * HTB)
#define PG8_SB(b, h) ((4 + (b) * 2 + (h)) * HTB)
#define PG8_STAGE(bufoff, gbase, voff) do { _Pragma("unroll") for (int _i = 0; _i < 2; ++_i) \
        __builtin_amdgcn_global_load_lds((const unsigned*)((const char*)(gbase) + (voff)[_i]), (PG8_LAS unsigned*)(lds + (bufoff) + ldsw + _i * 8192), 16, 0, 0); } while (0)
#define PG8_LDA(dst, b, h) do { _Pragma("unroll") for (int m = 0; m < 4; ++m) _Pragma("unroll") for (int k = 0; k < 2; ++k) dst[m][k] = *(const PG8_LAS bf16x8*)(lds + PG8_SA(b, h) + aoff + m * 2048 + k * 1024); } while (0)
#define PG8_LDB(dst, b, h) do { _Pragma("unroll") for (int n = 0; n < 2; ++n) _Pragma("unroll") for (int k = 0; k < 2; ++k) dst[n][k] = *(const PG8_LAS bf16x8*)(lds + PG8_SB(b, h) + boff + n * 2048 + k * 1024); } while (0)
#define PG8_MMA(ai, bj, At, Bt) do { __builtin_amdgcn_s_setprio(1); _Pragma("unroll") for (int m = 0; m < 4; ++m) _Pragma("unroll") for (int n = 0; n < 2; ++n) _Pragma("unroll") for (int k = 0; k < 2; ++k) \
        acc[ai][bj][m][n] = __builtin_amdgcn_mfma_f32_16x16x32_bf16(Bt[n][k], At[m][k], acc[ai][bj][m][n], 0, 0, 0); __builtin_amdgcn_s_setprio(0); } while (0)
#define PG8_WAIT_V(n) asm volatile("s_waitcnt vmcnt(" #n ")" ::: "memory")
#define PG8_WAIT_L(n) asm volatile("s_waitcnt lgkmcnt(" #n ")" ::: "memory")
#define PG8_BAR __builtin_amdgcn_s_barrier()
#define PG8_SCHED __builtin_amdgcn_sched_barrier(0)
    Unit cur, nxt; int ui = 0;
    if (!S.next(0, cur)) return;
    f32x4 acc[2][2][4][2];
#pragma unroll
    for (int a = 0; a < 2; ++a)
#pragma unroll
        for (int b = 0; b < 2; ++b)
#pragma unroll
            for (int m = 0; m < 4; ++m)
#pragma unroll
                for (int n = 0; n < 2; ++n) acc[a][b][m][n] = (f32x4){0.f, 0.f, 0.f, 0.f};
    bf16x8 At[4][2], B0[2][2], B1[2][2];
    const char* cA = (const char*)g.A + (size_t)cur.pm * tstep; const char* cB = (const char*)g.Bt + (size_t)cur.pn * tstep;
    S.a_ready(cur);
    if constexpr (SP2) {
        PG8_STAGE(PG8_SB(0, 0), cB, voffB); PG8_STAGE(PG8_SB(0, 1), cB + hstepB, voffB); PG8_STAGE(PG8_SA(0, 0), cA, voffA); PG8_STAGE(PG8_SA(0, 1), cA + hstep, voffA);
        if (wr == 1) PG8_BAR;
        PG8_WAIT_V(2); PG8_BAR;
        PG8_STAGE(PG8_SB(1, 0), cB + kstep, voffB); PG8_STAGE(PG8_SA(1, 0), cA + kstep, voffA); PG8_STAGE(PG8_SB(1, 1), cB + hstepB + kstep, voffB);
        PG8_WAIT_V(6); PG8_BAR;
    } else {
        PG8_STAGE(PG8_SB(0, 0), cB, voffB); PG8_STAGE(PG8_SA(0, 0), cA, voffA); PG8_STAGE(PG8_SB(0, 1), cB + hstepB, voffB); PG8_STAGE(PG8_SA(0, 1), cA + hstep, voffA);
        if (wr == 1) PG8_BAR;
        PG8_WAIT_V(4); PG8_BAR;
        PG8_STAGE(PG8_SB(1, 0), cB + kstep, voffB); PG8_STAGE(PG8_SA(1, 0), cA + kstep, voffA); PG8_STAGE(PG8_SB(1, 1), cB + hstepB + kstep, voffB);
        PG8_WAIT_V(6); PG8_BAR;
    }
    for (;;) {
        const bool has_next = S.next(ui + 1, nxt);
        const char* nA = has_next ? (const char*)g.A + (size_t)nxt.pm * tstep : cA; const char* nB = has_next ? (const char*)g.Bt + (size_t)nxt.pn * tstep : cB;
        for (int t = 0; t < nt; t += 2) {
            const bool last = (t == nt - 2);
            const char* a1 = cA + (size_t)(t + 1) * kstep;
            const char* a2 = last ? nA : cA + (size_t)(t + 2) * kstep; const char* b2 = last ? nB : cB + (size_t)(t + 2) * kstep;
            const char* a3 = a2 + kstep; const char* b3 = b2 + kstep;
            if (last && has_next) S.a_ready(nxt);
            if constexpr (SP2) {
            PG8_LDB(B0, 0, 0); PG8_LDB(B1, 0, 1); PG8_SCHED; PG8_LDA(At, 0, 0); PG8_STAGE(PG8_SA(1, 1), a1 + hstep, voffA);
            PG8_WAIT_V(8); PG8_WAIT_L(0); PG8_BAR; PG8_MMA(0, 0, At, B0); PG8_MMA(0, 1, At, B1); PG8_BAR; PG8_SCHED;
            PG8_LDA(At, 0, 1); PG8_STAGE(PG8_SB(0, 0), b2, voffB); PG8_STAGE(PG8_SB(0, 1), b2 + hstepB, voffB); PG8_STAGE(PG8_SA(0, 0), a2, voffA);
            PG8_WAIT_V(8); PG8_WAIT_L(0); PG8_BAR; PG8_MMA(1, 0, At, B0); PG8_MMA(1, 1, At, B1); PG8_BAR; PG8_SCHED;
            PG8_LDB(B0, 1, 0); PG8_LDB(B1, 1, 1); PG8_SCHED; PG8_LDA(At, 1, 0); PG8_STAGE(PG8_SA(0, 1), a2 + hstep, voffA);
            PG8_WAIT_V(8); PG8_WAIT_L(0); PG8_BAR; PG8_MMA(0, 0, At, B0); PG8_MMA(0, 1, At, B1); PG8_BAR; PG8_SCHED;
            PG8_LDA(At, 1, 1); PG8_STAGE(PG8_SB(1, 0), b3, voffB); PG8_STAGE(PG8_SB(1, 1), b3 + hstepB, voffB); PG8_STAGE(PG8_SA(1, 0), a3, voffA);
            PG8_WAIT_V(8); PG8_WAIT_L(0); PG8_BAR; PG8_MMA(1, 0, At, B0); PG8_MMA(1, 1, At, B1); PG8_BAR; PG8_SCHED;
            } else {
            PG8_LDB(B0, 0, 0); PG8_SCHED; PG8_LDA(At, 0, 0); PG8_STAGE(PG8_SA(1, 1), a1 + hstep, voffA);
            PG8_WAIT_L(8); PG8_BAR; PG8_WAIT_L(0); PG8_MMA(0, 0, At, B0); PG8_BAR; PG8_SCHED;
            PG8_LDB(B1, 0, 1); PG8_STAGE(PG8_SB(0, 0), b2, voffB);
            PG8_BAR; PG8_WAIT_L(0); PG8_MMA(0, 1, At, B1); PG8_BAR;
            PG8_LDA(At, 0, 1); PG8_STAGE(PG8_SA(0, 0), a2, voffA);
            PG8_BAR; PG8_WAIT_L(0); PG8_MMA(1, 0, At, B0); PG8_BAR; PG8_SCHED;
            PG8_STAGE(PG8_SB(0, 1), b2 + hstepB, voffB);
            PG8_WAIT_V(6); PG8_BAR; PG8_MMA(1, 1, At, B1); PG8_BAR;
            PG8_LDB(B0, 1, 0); PG8_SCHED; PG8_LDA(At, 1, 0); PG8_STAGE(PG8_SA(0, 1), a2 + hstep, voffA);
            PG8_WAIT_L(8); PG8_BAR; PG8_WAIT_L(0); PG8_MMA(0, 0, At, B0); PG8_BAR; PG8_SCHED;
            PG8_LDB(B1, 1, 1); PG8_STAGE(PG8_SB(1, 0), b3, voffB);
            PG8_BAR; PG8_WAIT_L(0); PG8_MMA(0, 1, At, B1); PG8_BAR;
            PG8_LDA(At, 1, 1); PG8_STAGE(PG8_SA(1, 0), a3, voffA);
            PG8_BAR; PG8_WAIT_L(0); PG8_MMA(1, 0, At, B0); PG8_BAR; PG8_SCHED;
            PG8_STAGE(PG8_SB(1, 1), b3 + hstepB, voffB);
            PG8_WAIT_V(6); PG8_BAR; PG8_MMA(1, 1, At, B1); PG8_BAR;
            }
        }
        if constexpr (ALIGN_EPI) { if (wr == 0) PG8_BAR; }
        if constexpr (!Epi::AFTER_DRAIN) { E(acc, cur, wr, wc, fr, fq); S.done(cur); }
        if (!has_next) break;
#pragma unroll
        for (int a = 0; a < 2; ++a)
#pragma unroll
            for (int b = 0; b < 2; ++b)
#pragma unroll
                for (int m = 0; m < 4; ++m)
#pragma unroll
                    for (int n = 0; n < 2; ++n) acc[a][b][m][n] = (f32x4){0.f, 0.f, 0.f, 0.f};
        cur = nxt; cA = nA; cB = nB; ++ui;
        if constexpr (ALIGN_EPI) { if (wr == 1) PG8_BAR; }
    }
    PG8_WAIT_V(0);
    if constexpr (!ALIGN_EPI) { if (wr == 0) PG8_BAR; }
    PG8_BAR;
    if constexpr (Epi::AFTER_DRAIN) { E.fused(acc, cur, wr, wc, fr, fq, lds, wid, lane); S.done(cur); }
#undef PG8_SA
#undef PG8_SB
#undef PG8_STAGE
#undef PG8_LDA
#undef PG8_LDB
#undef PG8_MMA
#undef PG8_WAIT_V
#undef PG8_WAIT_L
#undef PG8_BAR
#undef PG8_SCHED
}
}

constexpr int NWAVES = 8, NTHR = 512;
constexpr int DM = 1024, BATCH = 8, SEQ = 4096, DEPTH = 4, NA = 2;
constexpr int M = BATCH * SEQ;
constexpr int HD = 64, MEMLEN = 256, MAINW = 768, DFF = 4096;
constexpr int MROWS = BATCH * MEMLEN;
constexpr float EPS = 1e-6f;
constexpr float LOG2E = 1.4426950408889634f;

constexpr size_t MiB = 1u << 20;
constexpr size_t WS_WIN = 0;
constexpr size_t WS_WOUT = 12 * MiB;
constexpr size_t WS_WUP = 20 * MiB;
constexpr size_t WS_WDN = 52 * MiB;
constexpr size_t WS_WMKV = 84 * MiB;
constexpr size_t WS_WPOOL = 88 * MiB;
constexpr size_t WS_MEMN = 92 * MiB;
constexpr size_t WS_MKV = 96 * MiB;
constexpr size_t WS_KV = 104 * MiB;
constexpr size_t WS_XN = 136 * MiB;
constexpr size_t WS_BIG = 200 * MiB;
constexpr size_t WS_CTL = 456 * MiB;
constexpr size_t CTL_BYTES = 65536;
constexpr size_t WS_SSQ = 457 * MiB;
constexpr size_t WS_END = 461 * MiB;

constexpr int LDS_BYTES = 155648;
constexpr int EPI_SCR_OFF = 135168;
constexpr int MISC_OFF = 131072;

#define LAS __attribute__((address_space(3)))
typedef unsigned short bf16;
typedef unsigned v4u __attribute__((ext_vector_type(4)));
typedef unsigned v2u __attribute__((ext_vector_type(2)));
typedef float f32x4 __attribute__((ext_vector_type(4)));
typedef float f32x16 __attribute__((ext_vector_type(16)));
typedef short bf16x8 __attribute__((ext_vector_type(8)));
typedef short s16x4 __attribute__((ext_vector_type(4)));
#define LDS_WAIT() asm volatile("s_waitcnt lgkmcnt(0)" ::: "memory")
__device__ __forceinline__ unsigned pk2(float lo, float hi) { return pg8::cvt_pk_bf16(lo, hi); }
__device__ __forceinline__ float bf_lo(unsigned u) { return __uint_as_float(u << 16); }
__device__ __forceinline__ float bf_hi(unsigned u) { return __uint_as_float(u & 0xffff0000u); }
__device__ __forceinline__ void unpack8(const v4u r, float* f) { f[0] = bf_lo(r.x); f[1] = bf_hi(r.x); f[2] = bf_lo(r.y); f[3] = bf_hi(r.y); f[4] = bf_lo(r.z); f[5] = bf_hi(r.z); f[6] = bf_lo(r.w); f[7] = bf_hi(r.w); }
__device__ __forceinline__ v4u pack8(const float* f) { v4u o; o.x = pk2(f[0], f[1]); o.y = pk2(f[2], f[3]); o.z = pk2(f[4], f[5]); o.w = pk2(f[6], f[7]); return o; }
__device__ __forceinline__ float wave_sum(float v) {
#pragma unroll
    for (int o = 1; o < 64; o <<= 1) v += __shfl_xor(v, o);
    return v;
}
#define XB_TMO      128
#define XB_XCNT(j)  (256  + 64 * (j))
#define XB_XSUB(j)  (1280 + 64 * (j))
#define XB_XGEN(j)  (2304 + 64 * (j))
#define XB_TOP      3328
#define XB_TOPGEN   3392
#define XCD_BAR_WORDS 3456
#define XB_SPIN_CAP (1u << 18)

__device__ __forceinline__ unsigned xb_ld(unsigned* p)              { return __hip_atomic_load(p, __ATOMIC_RELAXED, __HIP_MEMORY_SCOPE_AGENT); }
__device__ __forceinline__ unsigned xb_add(unsigned* p, unsigned v) { return __hip_atomic_fetch_add(p, v, __ATOMIC_RELAXED, __HIP_MEMORY_SCOPE_AGENT); }
__device__ __forceinline__ unsigned xb_xcc_id() { return (unsigned)__builtin_amdgcn_s_getreg((3 << 11) | 20) & 0xFu; }
#define XB_SPIN(cond, bar) do { unsigned _sp = 0; while (cond) { __builtin_amdgcn_s_sleep(1); \
    if ((++_sp & 255u) == 0u) { if (xb_ld(&(bar)[XB_TMO])) break; if (_sp > XB_SPIN_CAP) { atomicAdd(&(bar)[XB_TMO], 1u); break; } } } } while (0)

struct XcdBarrier {
    unsigned* bar; unsigned x;
    volatile LAS unsigned* st;
};

__device__ __forceinline__ XcdBarrier xcd_barrier_post(unsigned* bar, volatile LAS unsigned* st) {
    XcdBarrier b; b.bar = bar; b.x = xb_xcc_id(); b.st = st;
    if (threadIdx.x == 0) (void)xb_add(&bar[XB_XCNT(b.x)], 1u);
    return b;
}
__device__ __forceinline__ void xcd_barrier_complete(unsigned* bar, unsigned x, unsigned& nloc, unsigned& nx) {
    const unsigned G = gridDim.x * gridDim.y * gridDim.z;
    unsigned sum, cnt, mine, sp = 0u;
    for (;;) {
        sum = 0u; cnt = 0u; mine = 0u;
#pragma unroll
        for (unsigned j = 0; j < 16; ++j) { const unsigned c = xb_ld(&bar[XB_XCNT(j)]); sum += c; cnt += (c > 0u) ? 1u : 0u; mine = (j == x) ? c : mine; }
        if (sum == G) break;
        __builtin_amdgcn_s_sleep(1);
        if ((++sp & 255u) == 0u) { if (xb_ld(&bar[XB_TMO])) break; if (sp > XB_SPIN_CAP) { atomicAdd(&bar[XB_TMO], 1u); break; } }
    }
    nloc = mine > 0u ? mine : 1u; nx = cnt > 0u ? cnt : 1u;
}

__device__ __forceinline__ void xcd_barrier(const XcdBarrier& b) {
    asm volatile("s_waitcnt vmcnt(0)" ::: "memory");
    __syncthreads();
    if (threadIdx.x == 0) {
        unsigned* bar = b.bar;
        __builtin_amdgcn_s_waitcnt(0);
        unsigned nloc = b.st[0], nx = b.st[1];
        if (nloc == 0u) { xcd_barrier_complete(bar, b.x, nloc, nx); b.st[0] = nloc; b.st[1] = nx; }
        const unsigned old = xb_add(&bar[XB_XSUB(b.x)], 1u);
        const unsigned gen = old / nloc;
        if (old + 1u == (gen + 1u) * nloc) {
            __builtin_amdgcn_fence(__ATOMIC_RELEASE, "agent");
            asm volatile("s_waitcnt vmcnt(0)" ::: "memory");
            const unsigned og = xb_add(&bar[XB_TOP], 1u);
            const unsigned tg = og / nx;
            if (og + 1u == (tg + 1u) * nx) xb_add(&bar[XB_TOPGEN], 1u);
            else XB_SPIN(xb_ld(&bar[XB_TOPGEN]) == tg, bar);
            __builtin_amdgcn_fence(__ATOMIC_ACQUIRE, "agent");
            xb_add(&bar[XB_XGEN(b.x)], 1u);
            asm volatile("s_waitcnt vmcnt(0)" ::: "memory");
        } else {
            XB_SPIN(xb_ld(&bar[XB_XGEN(b.x)]) == gen, bar);
            __builtin_amdgcn_fence(__ATOMIC_ACQUIRE, "agent");
            asm volatile("s_waitcnt vmcnt(0)" ::: "memory");
        }
    }
    __syncthreads();
}

namespace att {
constexpr int KP = 144;
constexpr int OS_PITCH = 144, OS_BYTES = 32 * OS_PITCH;
__device__ __forceinline__ int crow(int r, int hi) { return (r & 3) + 8 * (r >> 2) + 4 * hi; }

struct StageRegs { v4u kr[6], va[3], vb[3]; };
template <int NKEYS>
__device__ __forceinline__ void stage_load(StageRegs& R, const bf16* ksrc, const bf16* vsrc, int pitch, int first_valid, int tid) {
    constexpr int NK = NKEYS * 8 / NTHR, NV = NKEYS * 4 / NTHR;
    const int c = tid & 7, r0 = tid >> 3;
#pragma unroll
    for (int it = 0; it < NK; ++it) { const int row = r0 + it * (NTHR / 8); R.kr[it] = (v4u){0u, 0u, 0u, 0u}; if (row >= first_valid) R.kr[it] = *(const v4u*)(ksrc + (long)row * pitch + 8 * c); }
#pragma unroll
    for (int it = 0; it < NV; ++it) { const int kp = r0 + it * (NTHR / 8); R.va[it] = (v4u){0u, 0u, 0u, 0u}; R.vb[it] = R.va[it];
        if (2 * kp >= first_valid) { R.va[it] = *(const v4u*)(vsrc + (long)(2 * kp) * pitch + 8 * c); R.vb[it] = *(const v4u*)(vsrc + (long)(2 * kp + 1) * pitch + 8 * c); } }
#pragma unroll
    for (int it = NK; it < 6; ++it) R.kr[it] = (v4u){0u, 0u, 0u, 0u};
#pragma unroll
    for (int it = NV; it < 3; ++it) { R.va[it] = (v4u){0u, 0u, 0u, 0u}; R.vb[it] = (v4u){0u, 0u, 0u, 0u}; }
}
template <int NKEYS, int VP>
__device__ __forceinline__ void stage_write(const StageRegs& R, LAS unsigned char* Kl, LAS unsigned char* Vt, const float* gain, int tid) {
    constexpr int NK = NKEYS * 8 / NTHR, NV = NKEYS * 4 / NTHR;
    const int c = tid & 7, r0 = tid >> 3;
    float g[8];
#pragma unroll
    for (int i = 0; i < 8; ++i) g[i] = gain[8 * c + i];
#pragma unroll
    for (int it = 0; it < NK; ++it) {
        const int row = r0 + it * (NTHR / 8);
        float f[8]; unpack8(R.kr[it], f);
        float ss = 0.f;
#pragma unroll
        for (int i = 0; i < 8; ++i) ss += f[i] * f[i];
        ss += __shfl_xor(ss, 1); ss += __shfl_xor(ss, 2); ss += __shfl_xor(ss, 4);
        const float rstd = __builtin_amdgcn_rsqf(ss * (1.0f / 64.0f) + EPS);
#pragma unroll
        for (int i = 0; i < 8; ++i) f[i] = f[i] * rstd * g[i];
        *(LAS v4u*)(Kl + row * KP + 16 * c) = pack8(f);
    }
#pragma unroll
    for (int it = 0; it < NV; ++it) {
        const int kp = r0 + it * (NTHR / 8);
        const v4u a = R.va[it], b = R.vb[it];
        LAS unsigned char* p = Vt + (8 * c) * VP + 4 * kp;
        *(LAS unsigned*)(p + 0 * VP) = (a.x & 0xffffu) | (b.x << 16);
        *(LAS unsigned*)(p + 1 * VP) = (a.x >> 16) | (b.x & 0xffff0000u);
        *(LAS unsigned*)(p + 2 * VP) = (a.y & 0xffffu) | (b.y << 16);
        *(LAS unsigned*)(p + 3 * VP) = (a.y >> 16) | (b.y & 0xffff0000u);
        *(LAS unsigned*)(p + 4 * VP) = (a.z & 0xffffu) | (b.z << 16);
        *(LAS unsigned*)(p + 5 * VP) = (a.z >> 16) | (b.z & 0xffff0000u);
        *(LAS unsigned*)(p + 6 * VP) = (a.w & 0xffffu) | (b.w << 16);
        *(LAS unsigned*)(p + 7 * VP) = (a.w >> 16) | (b.w & 0xffff0000u);
    }
}
struct QRaw { v4u r[4]; };
__device__ __forceinline__ void q_load(QRaw& q, const bf16* Q, int qpitch, int lane) {
    const bf16* qp = Q + (long)(lane & 31) * qpitch + 8 * (lane >> 5);
#pragma unroll
    for (int s = 0; s < 4; ++s) q.r[s] = *(const v4u*)(qp + 16 * s);
}
struct QLine { v4u r[4]; };
__device__ __forceinline__ void q_load_lines(QLine& q, const bf16* Q, int qpitch, int lane) {
    const bf16* qp = Q + (long)(lane >> 3) * qpitch + 8 * (lane & 7);
#pragma unroll
    for (int k = 0; k < 4; ++k) q.r[k] = *(const v4u*)(qp + (long)(8 * k) * qpitch);
}
__device__ __forceinline__ void q_redistribute(const QLine& ql, QRaw& q, LAS unsigned char* stage, int lane) {
#pragma unroll
    for (int k = 0; k < 4; ++k) *(LAS v4u*)(stage + (8 * k + (lane >> 3)) * OS_PITCH + 16 * (lane & 7)) = ql.r[k];
#pragma unroll
    for (int s = 0; s < 4; ++s) q.r[s] = *(const LAS v4u*)(stage + (lane & 31) * OS_PITCH + (2 * s + (lane >> 5)) * 16);
}
__device__ __forceinline__ void q_gains(const float* gq, int lane, f32x4 (&gv)[8]) {
#pragma unroll
    for (int s = 0; s < 4; ++s) { gv[2 * s] = *(const f32x4*)(gq + 16 * s + 8 * (lane >> 5)); gv[2 * s + 1] = *(const f32x4*)(gq + 16 * s + 8 * (lane >> 5) + 4); }
}
__device__ __forceinline__ void q_norm(const QRaw& q, const f32x4 (&gv)[8], int lane, bf16x8 (&qf)[4]) {
    float f[4][8]; float ss = 0.f;
#pragma unroll
    for (int s = 0; s < 4; ++s) { unpack8(q.r[s], f[s]);
#pragma unroll
        for (int j = 0; j < 8; ++j) ss += f[s][j] * f[s][j]; }
    ss += __shfl_xor(ss, 32);
    const float rstd = (0.125f * LOG2E) * __builtin_amdgcn_rsqf(ss * (1.0f / 64.0f) + EPS);
#pragma unroll
    for (int s = 0; s < 4; ++s) {
#pragma unroll
        for (int j = 0; j < 8; ++j) f[s][j] = f[s][j] * rstd * gv[2 * s + (j >> 2)][j & 3];
        qf[s] = __builtin_bit_cast(bf16x8, pack8(f[s]));
    }
}
__device__ __forceinline__ float score_bound2(const float* gq, const float* gk, int lane) {
    float a = fabsf(gq[lane]), b = fabsf(gk[lane]);
#pragma unroll
    for (int o = 1; o < 64; o <<= 1) { a = fmaxf(a, __shfl_xor(a, o)); b = fmaxf(b, __shfl_xor(b, o)); }
    return 8.1f * a * b * LOG2E;
}
template <int NKT, bool SWA, int VP, int NH>
__device__ __forceinline__ void task(LAS const unsigned char* Kl, LAS const unsigned char* Vt, const bf16x8 (&qf)[NH][4],
                                     bf16* const (&O)[NH], int opitch, const float (&slope2)[NH], const float (&sink2)[NH], const float (&shift2)[NH], int kt_first, int lane, LAS unsigned char* oscr) {
    const int ql = lane & 31, hi = lane >> 5;
    int qh = ql - 4 * hi; asm volatile("" : "+v"(qh));
    float base[NH];
#pragma unroll
    for (int h = 0; h < NH; ++h) { base[h] = -shift2[h]; if (SWA) base[h] -= slope2[h] * (float)(qh + 128); }
    const short one = (ql == 0) ? (short)0x3F80 : (short)0;
    const bf16x8 onesf = (bf16x8){one, one, one, one, one, one, one, one};
    constexpr bool ONES = (NH == 1);
    f32x16 Oa[NH][ONES ? 3 : 2]; float vsum[NH];
#pragma unroll
    for (int h = 0; h < NH; ++h) { vsum[h] = 0.f; Oa[h][0] = (f32x16){0.f, 0.f, 0.f, 0.f, 0.f, 0.f, 0.f, 0.f, 0.f, 0.f, 0.f, 0.f, 0.f, 0.f, 0.f, 0.f}; Oa[h][1] = Oa[h][0]; if (ONES) Oa[h][ONES ? 2 : 0] = Oa[h][0]; }
#pragma unroll
    for (int kt = 0; kt < NKT; ++kt) {
        if (SWA && kt < kt_first) continue;
        f32x16 S[NH];
#pragma unroll
        for (int h = 0; h < NH; ++h)
#pragma unroll
            for (int r = 0; r < 16; ++r) {
                const int cr = (r & 3) + 8 * (r >> 2);
                float c = base[h];
                if (SWA) {
                    c = fmaf(slope2[h], (float)(32 * kt + cr), base[h]);
                    if (kt == 0) c = (cr > qh) ? c : -1e30f;
                    if (kt == NKT - 1) c = (cr <= qh) ? c : -1e30f;
                }
                S[h][r] = c;
            }
#pragma unroll
        for (int s = 0; s < 4; ++s) {
            const bf16x8 kf = *(LAS const bf16x8*)(Kl + (32 * kt + ql) * KP + (16 * s + 8 * hi) * 2);
#pragma unroll
            for (int h = 0; h < NH; ++h) S[h] = __builtin_amdgcn_mfma_f32_32x32x16_bf16(kf, qf[h][s], S[h], 0, 0, 0);
        }
#pragma unroll
        for (int h = 0; h < NH; ++h)
#pragma unroll
            for (int r = 0; r < 16; ++r) { S[h][r] = __builtin_amdgcn_exp2f(S[h][r]); if (!ONES) vsum[h] += S[h][r]; }
#pragma unroll
        for (int s = 0; s < 2; ++s) {
            bf16x8 pf[NH];
#pragma unroll
            for (int h = 0; h < NH; ++h) { v4u pw; pw.x = pk2(S[h][8 * s + 0], S[h][8 * s + 1]); pw.y = pk2(S[h][8 * s + 2], S[h][8 * s + 3]);
                pw.z = pk2(S[h][8 * s + 4], S[h][8 * s + 5]); pw.w = pk2(S[h][8 * s + 6], S[h][8 * s + 7]); pf[h] = __builtin_bit_cast(bf16x8, pw); }
#pragma unroll
            for (int dt = 0; dt < 2; ++dt) {
                LAS const unsigned char* vp = Vt + (32 * dt + ql) * VP + (32 * kt + 16 * s + 4 * hi) * 2;
                const s16x4 lo = *(LAS const s16x4*)vp; const s16x4 h4 = *(LAS const s16x4*)(vp + 16);
                const bf16x8 vf = (bf16x8){lo[0], lo[1], lo[2], lo[3], h4[0], h4[1], h4[2], h4[3]};
#pragma unroll
                for (int h = 0; h < NH; ++h) Oa[h][dt] = __builtin_amdgcn_mfma_f32_32x32x16_bf16(vf, pf[h], Oa[h][dt], 0, 0, 0);
            }
            if (ONES)
#pragma unroll
                for (int h = 0; h < NH; ++h) Oa[h][ONES ? 2 : 0] = __builtin_amdgcn_mfma_f32_32x32x16_bf16(onesf, pf[h], Oa[h][ONES ? 2 : 0], 0, 0, 0);
        }
        __builtin_amdgcn_sched_barrier(0);
    }
#pragma unroll
    for (int h = 0; h < NH; ++h) {
        float sum = ONES ? Oa[h][ONES ? 2 : 0][0] : vsum[h]; sum += __shfl_xor(sum, 32);
        if (SWA) sum += __builtin_amdgcn_exp2f(sink2[h] - shift2[h]);
        const float inv = 1.0f / sum;
        LAS unsigned char* so = oscr + ql * OS_PITCH + 8 * hi;
#pragma unroll
        for (int dt = 0; dt < 2; ++dt)
#pragma unroll
            for (int rg = 0; rg < 4; ++rg) {
                v2u w; w.x = pk2(Oa[h][dt][4 * rg + 0] * inv, Oa[h][dt][4 * rg + 1] * inv); w.y = pk2(Oa[h][dt][4 * rg + 2] * inv, Oa[h][dt][4 * rg + 3] * inv);
                *(LAS v2u*)(so + 64 * dt + 16 * rg) = w;
            }
        const int rr = lane >> 3, ch = lane & 7;
#pragma unroll
        for (int k = 0; k < 4; ++k) {
            const v4u l = *(const LAS v4u*)(oscr + (8 * k + rr) * OS_PITCH + 16 * ch);
            *(v4u*)(O[h] + (long)(8 * k + rr) * opitch + 8 * ch) = l;
        }
    }
}
constexpr int SWA_VP = 776, MEM_VP = 520;
__device__ __forceinline__ LAS unsigned char* out_stage(LAS unsigned char* lds, int wave) { return lds + ((wave < 5) ? (104960 + wave * OS_BYTES) : (131328 + (wave - 5) * OS_BYTES)); }
constexpr int SWA_VT_OFF = 384 * KP, MEM_VT_OFF = 256 * KP;
}

struct Args { const float* in[19]; float* out; unsigned char* ws; int ph_lo, ph_hi; };

struct MixP { const bf16* PROJ; const bf16* KV; const bf16* MKV; bf16* CAT; const float *knorm, *qnorm, *sinks, *mknorm, *mqnorm; int l; };
__device__ __forceinline__ void unit_load(const MixP& P, int v, int tid, int wave, att::StageRegs& R) {
    asm volatile("" : "+v"(tid));
    const int lane = tid & 63;
    if (v < 512) {
        const int b = v & 7, rem = v >> 3, kvh = rem >> 4, tb = rem & 15;     const long t0 = (long)b * SEQ + tb * 256;
        att::stage_load<384>(R, P.KV + (t0 - 128) * 512 + kvh * 64, P.KV + (t0 - 128) * 512 + 256 + kvh * 64, 512, (tb == 0) ? 128 : 0, tid);
    } else {
        const int u = v - 512, b = u & 7, rem = u >> 3, h = rem >> 3, tb = rem & 7; const long t0 = (long)b * SEQ + tb * 512;
        const bf16* ksrc = P.MKV + (long)(b * MEMLEN) * 2048 + P.l * 512 + h * 64;
        att::stage_load<256>(R, ksrc, ksrc + 256, 2048, 0, tid);
    }
}
__device__ __forceinline__ void unit_write(const MixP& P, int v, LAS unsigned char* lds, int tid, const att::StageRegs& R) {
    asm volatile("" : "+v"(tid));
    if (v < 512) att::stage_write<384, att::SWA_VP>(R, lds, lds + att::SWA_VT_OFF, P.knorm, tid);
    else att::stage_write<256, att::MEM_VP>(R, lds, lds + att::MEM_VT_OFF, P.mknorm + P.l * 64, tid);
}
__device__ __forceinline__ void unit_tasks(const MixP& P, int v, LAS unsigned char* lds, int tid, int wave) {
    asm volatile("" : "+v"(tid));
    const int lane = tid & 63;
    if (v < 512) {
        const int j = P.l - NA;
        const int b = v & 7, rem = v >> 3, kvh = rem >> 4, tb = rem & 15;     const long t0 = (long)b * SEQ + tb * 256;
        const int i = wave;
        att::QLine qcur; att::q_load_lines(qcur, P.PROJ + (t0 + 32 * i) * 1024 + (kvh * 3) * 64, 1024, lane);
        LAS unsigned char* const stage = att::out_stage(lds, wave);
        f32x4 gv[8]; att::q_gains(P.qnorm + j * 64, lane, gv);
        float sk3[3];
#pragma unroll
        for (int g = 0; g < 3; ++g) sk3[g] = P.sinks[j * 12 + kvh * 3 + g];
        const float bound2 = att::score_bound2(P.qnorm + j * 64, P.knorm, lane);
        LAS unsigned char* Kl = lds; LAS unsigned char* Vt = lds + att::SWA_VT_OFF;
        const int kt_first = (tb == 0) ? ((4 - i) > 0 ? (4 - i) : 0) : 0;
#pragma unroll 1
        for (int g = 0; g < 3; ++g) {
            const int hq = kvh * 3 + g;
            int ln = lane; asm volatile("" : "+v"(ln));
            att::QLine qn = qcur;
            if (g < 2) att::q_load_lines(qn, P.PROJ + (t0 + 32 * i) * 1024 + (hq + 1) * 64, 1024, ln);
            att::QRaw qr; att::q_redistribute(qcur, qr, stage, ln);
            bf16x8 qf[1][4]; att::q_norm(qr, gv, ln, qf[0]);
            const float slope2 = exp2f(-8.0f * (float)(hq + 1) / 12.0f) * LOG2E;
            const float sink2 = ((g == 0) ? sk3[0] : (g == 1) ? sk3[1] : sk3[2]) * LOG2E;
            const float shift2 = fmaxf(bound2, sink2);
            bf16* const O1[1] = {P.CAT + (t0 + 32 * i) * 1024 + hq * 64}; const float sl1[1] = {slope2}, sk1[1] = {sink2}, sh1[1] = {shift2};
            att::task<5, true, att::SWA_VP, 1>(Kl + 32 * i * att::KP, Vt + 32 * i * 2, qf, O1, 1024, sl1, sk1, sh1, kt_first, ln, stage);
            qcur = qn;
        }
    } else {
        const int u = v - 512, b = u & 7, rem = u >> 3, h = rem >> 3, tb = rem & 7; const long t0 = (long)b * SEQ + tb * 512;
        att::QLine ql0, ql1;
        att::q_load_lines(ql0, P.PROJ + (t0 + 32 * wave) * 1024 + MAINW + h * 64, 1024, lane);
        att::q_load_lines(ql1, P.PROJ + (t0 + 32 * (wave + 8)) * 1024 + MAINW + h * 64, 1024, lane);
        LAS unsigned char* const stage = att::out_stage(lds, wave);
        f32x4 gv[8]; att::q_gains(P.mqnorm + P.l * 64, lane, gv);
        const float bound2 = att::score_bound2(P.mqnorm + P.l * 64, P.mknorm + P.l * 64, lane);
        LAS unsigned char* Kl = lds; LAS unsigned char* Vt = lds + att::MEM_VT_OFF;
        int ln = lane; asm volatile("" : "+v"(ln));
        att::QRaw q0, q1; att::q_redistribute(ql0, q0, stage, ln); att::q_redistribute(ql1, q1, stage, ln);
        bf16x8 qf[2][4]; att::q_norm(q0, gv, ln, qf[0]); att::q_norm(q1, gv, ln, qf[1]);
        bf16* const cat = P.CAT + (t0 + 32 * wave) * 1024 + MAINW + h * 64;
        bf16* const O2[2] = {cat, cat + (long)256 * 1024};
        const float z2[2] = {0.f, 0.f}, sh2[2] = {bound2, bound2};
        att::task<8, false, att::MEM_VP, 2>(Kl, Vt, qf, O2, 1024, z2, z2, sh2, 0, ln, stage);
    }
}
template <int W>
__device__ __forceinline__ void pool_run(const bf16* up, bf16* dp, int tin) {
    constexpr int RUN = 32;
    v4u ring[W]; float s[8];
#pragma unroll
    for (int i = 0; i < 8; ++i) s[i] = 0.f;
#pragma unroll
    for (int k = 0; k < W; ++k) { ring[k] = (v4u){0u, 0u, 0u, 0u}; if (tin > 0) ring[k] = *(const v4u*)(up - (long)(W - k) * 1024); }
#pragma unroll
    for (int k = 0; k < W; ++k) { float f[8]; unpack8(ring[k], f);
#pragma unroll
        for (int i = 0; i < 8; ++i) s[i] += f[i]; }
#pragma unroll
    for (int tb = 0; tb < RUN; tb += 8) {
        v4u xr[8];
#pragma unroll
        for (int j = 0; j < 8; ++j) xr[j] = *(const v4u*)(up + (long)(tb + j) * 1024);
#pragma unroll
        for (int j = 0; j < 8; ++j) {
            const int t = tb + j;
            float x[8], p[8]; unpack8(xr[j], x); unpack8(ring[t % W], p);
            ring[t % W] = xr[j];
            const float rc = (tin > 0 || t + 1 >= W) ? (1.0f / (float)W) : (1.0f / (float)(t + 1));
            float d[8];
#pragma unroll
            for (int i = 0; i < 8; ++i) { s[i] += x[i] - p[i]; d[i] = s[i] * rc - x[i]; }
            *(v4u*)(dp + (long)t * 1024) = pack8(d);
        }
        asm volatile("" ::: "memory");
    }
}
__device__ __forceinline__ void pool_pass(const bf16* PROJ, bf16* DOUT, int bx, int G, int wave, int lane) {
    if (wave >= 6) return;
    for (int wi = bx * 6 + wave; wi < 4 * 3 * 128; wi += G * 6) {
        int g = wi / 384, rem = wi - g * 384, cb = rem >> 7, rb = rem & 127;
        if (G == 256) {
            const int k = (bx >> 3) * 6 + wave; g = k / 48; const int r2 = k - g * 48; cb = r2 >> 4; rb = (bx & 7) * 16 + (r2 & 15);
        }
        const int run = rb * 8 + (lane >> 3), c = g * 24 + cb * 8 + (lane & 7);
        const long t0 = (long)run * 32; const int tin = (int)(t0 & (SEQ - 1));
        const bf16* up = PROJ + t0 * 1024 + 8 * c; bf16* dp = DOUT + t0 * 1024 + 8 * c;
        if (g == 0) pool_run<2>(up, dp, tin); else if (g == 1) pool_run<4>(up, dp, tin); else if (g == 2) pool_run<8>(up, dp, tin); else pool_run<16>(up, dp, tin);
    }
}

enum { I_X = 0, I_MEM, I_NORM_MIX, I_W_IN, I_POOL_W, I_POOL_SCALE, I_KV_NORM, I_W_KV, I_K_NORM, I_Q_NORM, I_SINKS, I_MEM_NORM, I_W_MEM_KV,
       I_MEM_Q_NORM, I_MEM_K_NORM, I_W_OUT, I_NORM_MLP, I_W_UP, I_W_DOWN };

constexpr int NTR = 2048 + 2048 + 8192 + 8192 + 1024 + 256;
constexpr size_t WS_TMPA = WS_BIG + 128 * MiB, WS_PP = WS_BIG + 136 * MiB;
struct TrD { const float* W; bf16* WT; const float* gk; int ldw, ldt; };
__device__ __forceinline__ void tr_load(const TrD& d, f32x4 (&v)[8], int lane) {
#pragma unroll
    for (int i = 0; i < 8; ++i) v[i] = *(const f32x4*)(d.W + (size_t)(8 * i + (lane >> 3)) * d.ldw + 4 * (lane & 7));
}
__device__ __forceinline__ void tr_store(const TrD& d, const f32x4 (&v)[8], LAS float* scr, int lane) {
#pragma unroll
    for (int i = 0; i < 8; ++i) { LAS float* p = scr + (8 * i + (lane >> 3)) * 33 + 4 * (lane & 7); p[0] = v[i][0]; p[1] = v[i][1]; p[2] = v[i][2]; p[3] = v[i][3]; }
    LDS_WAIT(); asm volatile("" ::: "memory");
    const int c = lane & 7;
    f32x4 g0 = (f32x4){1.f, 1.f, 1.f, 1.f}, g1 = g0;
    if (d.gk) { g0 = *(const f32x4*)(d.gk + 8 * c); g1 = *(const f32x4*)(d.gk + 8 * c + 4); }
#pragma unroll
    for (int j = 0; j < 4; ++j) { const int n = (lane >> 3) + 8 * j; const LAS float* s = scr + (8 * c) * 33 + n;
        v4u o; o.x = pk2(s[0 * 33] * g0[0], s[1 * 33] * g0[1]); o.y = pk2(s[2 * 33] * g0[2], s[3 * 33] * g0[3]); o.z = pk2(s[4 * 33] * g1[0], s[5 * 33] * g1[1]); o.w = pk2(s[6 * 33] * g1[2], s[7 * 33] * g1[3]);
        *(v4u*)(d.WT + (size_t)n * d.ldt + 8 * c) = o; }
    LDS_WAIT(); asm volatile("" ::: "memory");
}
__device__ __forceinline__ void rms_row(const float* xrow, bf16* orow, int lane) {
    const f32x4* xr = (const f32x4*)xrow + lane;
    f32x4 v[4]; float s = 0.f;
#pragma unroll
    for (int j = 0; j < 4; ++j) { v[j] = xr[64 * j]; s += (v[j].x * v[j].x + v[j].y * v[j].y) + (v[j].z * v[j].z + v[j].w * v[j].w); }
    const float rstd = 1.0f / sqrtf(wave_sum(s) * (1.0f / DM) + EPS);
    unsigned long long* o8 = (unsigned long long*)orow + lane;
#pragma unroll
    for (int j = 0; j < 4; ++j) o8[64 * j] = (unsigned long long)pk2(v[j].x * rstd, v[j].y * rstd) | ((unsigned long long)pk2(v[j].z * rstd, v[j].w * rstd) << 32);
}
struct XRows { f32x4 v[2][4]; };
__device__ __forceinline__ void xrows_load(XRows& x, const float* x0, const float* x1, int lane) {
    const f32x4* pa = (const f32x4*)x0 + 2 * lane; const f32x4* pb = (const f32x4*)x1 + 2 * lane;
#pragma unroll
    for (int j = 0; j < 2; ++j) { x.v[0][2 * j] = pa[128 * j]; x.v[0][2 * j + 1] = pa[128 * j + 1]; x.v[1][2 * j] = pb[128 * j]; x.v[1][2 * j + 1] = pb[128 * j + 1]; }
}
__device__ __forceinline__ void xrows_store(const XRows& x, bf16* o0, bf16* o1, float* q0, float* q1, int lane) {
    float ss[2];
#pragma unroll
    for (int r = 0; r < 2; ++r) {
        v4u* op = (v4u*)(r == 0 ? o0 : o1) + lane; float s = 0.f;
#pragma unroll
        for (int j = 0; j < 2; ++j) {
            const f32x4 a = x.v[r][2 * j], b = x.v[r][2 * j + 1];
            v4u w; w.x = pk2(a.x, a.y); w.y = pk2(a.z, a.w); w.z = pk2(b.x, b.y); w.w = pk2(b.z, b.w);
            const float r0 = bf_lo(w.x), r1 = bf_hi(w.x), r2 = bf_lo(w.y), r3 = bf_hi(w.y), r4 = bf_lo(w.z), r5 = bf_hi(w.z), r6 = bf_lo(w.w), r7 = bf_hi(w.w);
            s += ((r0 * r0 + r1 * r1) + (r2 * r2 + r3 * r3)) + ((r4 * r4 + r5 * r5) + (r6 * r6 + r7 * r7));
            op[64 * j] = w;
        }
        ss[r] = wave_sum(s);
    }
    if (lane < 16) { q0[lane] = (lane == 0) ? ss[0] : 0.f; q1[lane] = (lane == 0) ? ss[1] : 0.f; }
}
__device__ __forceinline__ void fold_item(const float* P, const float* scale, const float* Wo, bf16* WT, int item, int lane) {
    const int c0 = (item >> 4) * 8, n = (item & 15) * 64 + lane;
    float acc[8];
#pragma unroll
    for (int j = 0; j < 8; ++j) acc[j] = 0.f;
    for (int d = 0; d < 192; d += 4) {
        const f32x4 sc = *(const f32x4*)(scale + d);
        float w[4];
#pragma unroll
        for (int e = 0; e < 4; ++e) w[e] = Wo[(size_t)(d + e) * DM + n] * sc[e];
#pragma unroll
        for (int j = 0; j < 8; ++j) { const f32x4 p = *(const f32x4*)(P + (c0 + j) * 192 + d); acc[j] += (p[0] * w[0] + p[1] * w[1]) + (p[2] * w[2] + p[3] * w[3]); }
    }
    *(v4u*)(WT + (size_t)n * DM + c0) = pack8(acc);
}

__device__ __forceinline__ void tr_decode(const Args& a, unsigned char* ws, int r, TrD& d) {
    const float* W; bf16* WT; const float* gk = nullptr; int ldw, ldt, nblk, item;
    if (r < 2048) { const int l = r >> 9; item = r & 511; W = a.in[I_W_IN] + (size_t)l * DM * DM; ldw = DM; WT = (bf16*)(ws + WS_WIN + l * 3 * MiB); ldt = DM; nblk = 32; gk = a.in[I_NORM_MIX] + l * DM; }
    else if ((r -= 2048) < 2048) { const int l = r >> 9; item = r & 511;
        W = a.in[I_W_OUT] + (size_t)l * DM * DM; ldw = DM; WT = (bf16*)(ws + WS_WOUT + l * 2 * MiB); ldt = DM; nblk = 32;
        if (l < NA && item < 12 * 32) { WT = (bf16*)(ws + WS_TMPA + l * 2 * MiB); ldt = MAINW; } }
    else if ((r -= 2048) < 8192) { const int l = r >> 11; item = r & 2047; W = a.in[I_W_UP] + (size_t)l * DM * DFF; ldw = DFF; WT = (bf16*)(ws + WS_WUP + l * 8 * MiB); ldt = DM; nblk = 128; gk = a.in[I_NORM_MLP] + l * DM; }
    else if ((r -= 8192) < 8192) { const int l = r >> 11; item = r & 2047; W = a.in[I_W_DOWN] + (size_t)l * DFF * DM; ldw = DM; WT = (bf16*)(ws + WS_WDN + l * 8 * MiB); ldt = DFF; nblk = 32; }
    else if ((r -= 8192) < 1024) { const int l = r >> 8; item = r & 255; W = a.in[I_W_MEM_KV] + (size_t)l * DM * 512; ldw = 512; WT = (bf16*)(ws + WS_WMKV) + (size_t)l * 512 * DM; ldt = DM; nblk = 16; gk = a.in[I_MEM_NORM] + l * DM; }
    else { r -= 1024; item = r; W = a.in[I_W_KV]; ldw = 512; WT = (bf16*)(ws + WS_WIN + 2 * 3 * MiB) + (size_t)1024 * DM; ldt = DM; nblk = 16; gk = a.in[I_KV_NORM]; }
    const int kb = item / nblk, nb = item - kb * nblk, k0 = 64 * kb, n0 = 32 * nb;
    d.W = W + (size_t)k0 * ldw + n0; d.WT = WT + (size_t)n0 * ldt + k0; d.gk = gk ? gk + k0 : nullptr; d.ldw = ldw; d.ldt = ldt;
}
__device__ __forceinline__ void prologue(const Args& a, unsigned char* ws, LAS unsigned char* lds, int gw, int NGW, int lane, int wave) {
    LAS float* scr = (LAS float*)(lds + wave * 16384);
    {
        int it = gw; TrD dc; f32x4 vc[8];
        bool hc = it < NTR;
        if (hc) { tr_decode(a, ws, it, dc); tr_load(dc, vc, lane); }
        while (hc) {
            const int itn = it + NGW; const bool hn = itn < NTR;
            TrD dn = dc; f32x4 vn[8];
#pragma unroll
            for (int i = 0; i < 8; ++i) vn[i] = vc[i];
            if (hn) { tr_decode(a, ws, itn, dn); tr_load(dn, vn, lane); }
            tr_store(dc, vc, scr, lane);
            dc = dn;
#pragma unroll
            for (int i = 0; i < 8; ++i) vc[i] = vn[i];
            hc = hn; it = itn;
        }
    }
    for (int it = gw * 64 + lane; it < 2 * MAINW * (MAINW / 8); it += NGW * 64) {
        const int l = it / (MAINW * (MAINW / 8)), r = it - l * (MAINW * (MAINW / 8)), c = r / (MAINW / 8), ch = r - c * (MAINW / 8), g = c / 192;
        v4u o = (v4u){0u, 0u, 0u, 0u};
        if (ch / 24 == g) { const float* p = a.in[I_POOL_W] + ((size_t)(l * 4 + g) * 192 + (c - g * 192)) * 192 + (8 * ch - g * 192); const float* sc = a.in[I_POOL_SCALE] + l * MAINW + 8 * ch;
            const f32x4 p0 = *(const f32x4*)p, p1 = *(const f32x4*)(p + 4), s0 = *(const f32x4*)sc, s1 = *(const f32x4*)(sc + 4);
            o.x = pk2(p0[0] * s0[0], p0[1] * s0[1]); o.y = pk2(p0[2] * s0[2], p0[3] * s0[3]); o.z = pk2(p1[0] * s1[0], p1[1] * s1[1]); o.w = pk2(p1[2] * s1[2], p1[3] * s1[3]); }
        *(v4u*)((bf16*)(ws + WS_PP + l * 2 * MiB) + (size_t)c * MAINW + 8 * ch) = o;
    }
    for (int m = gw; m < MROWS; m += NGW) rms_row(a.in[I_MEM] + (size_t)m * DM, (bf16*)(ws + WS_MEMN) + (size_t)m * DM, lane);
    {
        int m = gw; XRows xc;
        if (m < M) xrows_load(xc, a.in[I_X] + (size_t)m * DM, a.in[I_X] + (size_t)(m + NGW) * DM, lane);
        while (m < M) {
            const int mn = m + 2 * NGW; XRows xn = xc;
            if (mn < M) xrows_load(xn, a.in[I_X] + (size_t)mn * DM, a.in[I_X] + (size_t)(mn + NGW) * DM, lane);
            xrows_store(xc, (bf16*)(ws + WS_XN) + (size_t)m * DM, (bf16*)(ws + WS_XN) + (size_t)(m + NGW) * DM,
                        (float*)(ws + WS_SSQ + 2 * MiB) + (size_t)m * 16, (float*)(ws + WS_SSQ + 2 * MiB) + (size_t)(m + NGW) * 16, lane);
            xc = xn; m = mn;
        }
    }
}

enum { K_PRO = 0, K_INPROJ, K_MIX, K_OUT, K_UP, K_DOWN };
constexpr int NPHASES = 21;
__device__ __forceinline__ void decode_phase(int ph, int& kind, int& l) {
    if (ph == 0) { kind = K_PRO; l = 0; return; }
    const int p = ph - 1; l = p / 5; const int k = p - 5 * l;
    kind = (k == 0) ? K_INPROJ : (k == 1) ? K_MIX : (k == 2) ? K_OUT : (k == 3) ? K_UP : K_DOWN;
}

__global__ void __launch_bounds__(NTHR, 2) fwd_kernel(Args a) {
    extern __shared__ __attribute__((aligned(16))) unsigned char lds_raw[];
    LAS unsigned char* lds = (LAS unsigned char*)lds_raw;
    volatile LAS unsigned* MISC = (volatile LAS unsigned*)(lds + MISC_OFF);
    if (threadIdx.x < 64) MISC[threadIdx.x] = 0u;
    __syncthreads();
    const int lo = a.ph_lo, hi = a.ph_hi;
    XcdBarrier bar; bar.bar = (unsigned*)(a.ws + WS_CTL); bar.x = 0; bar.st = nullptr;
    if (hi - lo > 1) bar = xcd_barrier_post((unsigned*)(a.ws + WS_CTL), MISC + 8);
    if (lo < 0) { cg::this_grid().sync(); }

    for (int ph = lo; ph < hi; ++ph) {
        int tid = threadIdx.x, bx = blockIdx.x, G = gridDim.x; unsigned long long zo = 0;
        asm volatile("" : "+v"(tid)); asm volatile("" : "+s"(bx), "+s"(G)); asm volatile("" : "+s"(zo));
        unsigned char* ws = a.ws + zo; float* outp = (float*)((unsigned char*)a.out + zo);
        const int lane = tid & 63, wave = __builtin_amdgcn_readfirstlane(tid >> 6);
        const int gw = bx * NWAVES + wave, NGW = G * NWAVES, gthread = bx * NTHR + tid, nthreads = G * NTHR;
        bf16* const XN = (bf16*)(ws + WS_XN);
        bf16* const PROJ = (bf16*)(ws + WS_BIG);
        bf16* const CAT = (bf16*)(ws + WS_BIG + 64 * MiB);
        bf16* const HID = (bf16*)(ws + WS_BIG);
        bf16* const KV = (bf16*)(ws + WS_KV);
        bf16* const MKV = (bf16*)(ws + WS_MKV);
        int kind, l; decode_phase(ph, kind, l);
        float* const SSQ0 = (float*)(ws + WS_SSQ);
        float* const SSQ1 = (float*)(ws + WS_SSQ + 2 * MiB);
        if (kind == K_PRO) {
            prologue(a, ws, lds, gw, NGW, lane, wave);
        } else if (kind == K_MIX) {
            MixP P; P.PROJ = PROJ; P.KV = KV; P.MKV = MKV; P.CAT = CAT; P.knorm = a.in[I_K_NORM]; P.qnorm = a.in[I_Q_NORM]; P.sinks = a.in[I_SINKS];
            P.mknorm = a.in[I_MEM_K_NORM]; P.mqnorm = a.in[I_MEM_Q_NORM]; P.l = l;
            att::StageRegs R;
            int v = (l < NA) ? 512 + bx : bx;
            if (l < NA) pool_pass(PROJ, CAT, bx, G, wave, lane);
            unit_load(P, v, tid, wave, R);
            while (v < 768) {
                unit_write(P, v, lds, tid, R);
                LDS_WAIT(); __syncthreads();
                const int vn = v + G;
                if (v < 512) { if (vn < 768) unit_load(P, vn, tid, wave, R); unit_tasks(P, v, lds, tid, wave); }
                else { unit_tasks(P, v, lds, tid, wave); if (vn < 768) unit_load(P, vn, tid, wave, R); }
                __syncthreads();
                v = vn;
            }
        } else {
            const int ng = (kind == K_INPROJ && l == 0) ? 4 : 1;
            for (int gi = 0; gi < ng; ++gi) {
                pg8::Gemm g; pg8::EpiB E; E.O2 = KV; E.ldc2 = 512; E.split_pn = 1 << 30; E.mode = 0; E.ssq_in = nullptr; E.ssq_out = SSQ0; E.outf = outp; E.scr = lds + EPI_SCR_OFF; g.M = M; g.K = DM;
                int cb = bx;
                if (kind == K_INPROJ && ng == 4 && gi == 0) { g.A = (const bf16*)(ws + WS_MEMN); g.Bt = (const bf16*)(ws + WS_WMKV); g.M = MROWS; g.N = 2048; E.O1 = MKV; E.ldc1 = 2048; }
                else if (kind == K_INPROJ && ng == 4 && gi < 3) {
                    const int fl = gi - 1; g.A = (const bf16*)(ws + WS_TMPA + fl * 2 * MiB); g.Bt = (const bf16*)(ws + WS_PP + fl * 2 * MiB); g.M = DM; g.N = MAINW; g.K = MAINW;
                    E.O1 = (bf16*)(ws + WS_WOUT + fl * 2 * MiB); E.ldc1 = DM; cb = (bx + G - 64 - 12 * fl) % G; }
                else if (kind == K_INPROJ) { g.A = XN; g.Bt = (const bf16*)(ws + WS_WIN + l * 3 * MiB); g.N = (l == 2) ? 1536 : 1024; E.O1 = PROJ; E.ldc1 = 1024; E.split_pn = 4; E.ssq_in = SSQ1; }
                else if (kind == K_OUT) { g.A = CAT; g.Bt = (const bf16*)(ws + WS_WOUT + l * 2 * MiB); g.N = DM; E.O1 = XN; E.ldc1 = DM; E.mode = 2; }
                else if (kind == K_UP) { g.A = XN; g.Bt = (const bf16*)(ws + WS_WUP + l * 8 * MiB); g.N = DFF; E.O1 = HID; E.ldc1 = DFF; E.mode = 1; }
                else { g.A = HID; g.Bt = (const bf16*)(ws + WS_WDN + l * 8 * MiB); g.N = DM; g.K = DFF; E.O1 = XN; E.ldc1 = DM; E.mode = (l == DEPTH - 1) ? 3 : 2; E.ssq_in = SSQ0; E.ssq_out = SSQ1; }
                pg8::StaticOrder S; S.init(g.M, g.N, G, cb);
                pg8::gemm_phase<pg8::EpiB, pg8::StaticOrder, true, true>(lds, g, S, E);
            }
        }
        if (ph + 1 < hi) { bar.bar = (unsigned*)(ws + WS_CTL); xcd_barrier(bar); }
    }
}

#ifndef PER_PHASE_LAUNCH
#define PER_PHASE_LAUNCH 0
#endif
extern "C" void kernel_launch(void* const* d_in, const int* in_sizes, int n_in, void* d_out, int out_size, void* d_ws, size_t ws_size, hipStream_t stream) {
    static int grid = 0;
    if (grid == 0) {
        if (n_in != 19 || out_size != M * DM || ws_size < WS_END) { fprintf(stderr, "kernel_launch: unexpected shapes (n_in %d out %d ws %zu)\n", n_in, out_size, ws_size); grid = -1; return; }
        int dev = 0, cus = 0, per_cu = 0;
        if (hipGetDevice(&dev) != hipSuccess || hipDeviceGetAttribute(&cus, hipDeviceAttributeMultiprocessorCount, dev) != hipSuccess) { grid = -1; return; }
        if (hipFuncSetAttribute((const void*)fwd_kernel, hipFuncAttributeMaxDynamicSharedMemorySize, LDS_BYTES) != hipSuccess) { fprintf(stderr, "kernel_launch: hipFuncSetAttribute failed\n"); grid = -1; return; }
        if (hipOccupancyMaxActiveBlocksPerMultiprocessor(&per_cu, (const void*)fwd_kernel, NTHR, LDS_BYTES) != hipSuccess || per_cu < 1) { fprintf(stderr, "kernel_launch: occupancy query says %d\n", per_cu); per_cu = 1; }
        (void)hipGetLastError();
        grid = cus < 256 ? cus : 256;
    }
    if (grid < 0) return;
    (void)hipMemsetAsync((char*)d_ws + WS_CTL, 0, CTL_BYTES, stream);
    Args a{};
    for (int i = 0; i < 19; ++i) a.in[i] = (const float*)d_in[i];
    a.out = (float*)d_out; a.ws = (unsigned char*)d_ws;
#if PER_PHASE_LAUNCH
    for (int ph = 0; ph < NPHASES; ++ph) {
        a.ph_lo = ph; a.ph_hi = ph + 1;
        hipLaunchKernelGGL(fwd_kernel, dim3(grid), dim3(NTHR), LDS_BYTES, stream, a);
    }
#else
    a.ph_lo = 0; a.ph_hi = NPHASES;
    void* params[] = {&a};
    hipError_t e = hipLaunchCooperativeKernel((const void*)fwd_kernel, dim3(grid), dim3(NTHR), params, LDS_BYTES, stream);
    if (e != hipSuccess) fprintf(stderr, "cooperative launch failed: %s (grid %d)\n", hipGetErrorString(e), grid);
#endif
}
```

```cpp
#include <hip/hip_runtime.h>
#include <hip/hip_cooperative_groups.h>
#include <cstdio>
#include <cstdint>
namespace cg = cooperative_groups;
namespace pg8 {
#define PG8_LAS __attribute__((address_space(3)))
typedef unsigned short bf16_t;
typedef short bf16x8 __attribute__((ext_vector_type(8)));
typedef float f32x4 __attribute__((ext_vector_type(4)));
typedef unsigned u32x4 __attribute__((ext_vector_type(4)));
constexpr int BM = 256, BK = 64, HALF = 128, HTB = HALF * BK * 2  , STAGE_BYTES = 8 * HTB, NXCD = 8, WGM = 8;

__host__ __device__ __forceinline__ int lds_byte(int r, int c) { const int st = (r >> 4) * 2 + (c >> 5), rr = r & 15, cc = c & 31, ob = rr * 64 + cc * 2; return st * 1024 + (ob ^ (((ob >> 9) & 1) << 5)); }
__host__ __device__ __forceinline__ void stage_rc(int b, int& R, int& C) { const int st = b / 1024, sb = b % 1024, swz = sb ^ (((sb >> 9) & 1) << 5); R = (st >> 1) * 16 + swz / 64; C = (st & 1) * 32 + (swz % 64) / 2; }
__host__ __device__ __forceinline__ int perm32(int rho) { const int n = rho >> 4, i = rho & 15; return 8 * (i >> 2) + 4 * n + (i & 3); }

struct Unit { int pm, pn; };
struct Gemm { const bf16_t* A; const bf16_t* Bt; int M, N, K; };

struct StaticOrder {
    int nM, nN, nwg, G, c;
    __host__ __device__ void init(int M, int N, int G_, int c_) { nM = M / BM; nN = N / BM; nwg = nM * nN; G = G_; c = c_; }
    __host__ __device__ bool next(int i, Unit& u) const {
        const long L = (long)i * G + c; if (L >= nwg) return false;
        int wgid = (int)L; { const int q = nwg / NXCD, r = nwg % NXCD, xcd = wgid % NXCD, off = wgid / NXCD; wgid = (xcd < r ? xcd * (q + 1) : r * (q + 1) + (xcd - r) * q) + off; }
        const int nig = WGM * nN, gid = wgid / nig, fm = gid * WGM, gsz = (nM - fm) < WGM ? (nM - fm) : WGM;
        u.pm = fm + ((wgid % nig) % gsz); u.pn = (wgid % nig) / gsz; return true;
    }
    __device__ __forceinline__ void a_ready(const Unit&) const {}
    __device__ __forceinline__ void done(const Unit&) const {}
};

typedef float f32x2 __attribute__((ext_vector_type(2)));
typedef __bf16 bf16x2_t __attribute__((ext_vector_type(2)));
__device__ __forceinline__ unsigned cvt_pk_bf16(float lo, float hi) { f32x2 v = {lo, hi}; bf16x2_t b = __builtin_convertvector(v, bf16x2_t); return __builtin_bit_cast(unsigned, b); }
__device__ __forceinline__ float bflo(unsigned u) { return __builtin_bit_cast(float, u << 16); }
__device__ __forceinline__ float bfhi(unsigned u) { return __builtin_bit_cast(float, u & 0xffff0000u); }

#ifndef EPI_ST
#define EPI_ST 0
#endif
__device__ __forceinline__ void st16(void* p, u32x4 v) {
#if EPI_ST == 1
    asm volatile("global_store_dwordx4 %0, %1, off sc1\n\ts_nop 1" :: "v"(p), "v"(v) : "memory");
#elif EPI_ST == 2
    __builtin_nontemporal_store(v, (u32x4*)p);
#else
    *(u32x4*)p = v;
#endif
}
__device__ __forceinline__ float relu_f(float x) { float y; asm("v_max_f32_e32 %0, 0, %1" : "=v"(y) : "v"(x)); return y; }
struct EpiB {
    static constexpr bool PERM = true, AFTER_DRAIN = false, WIDE = true;
    static constexpr int SCR_PITCH = 144, SCR_BYTES = 16 * SCR_PITCH;
    bf16_t* O1; int ldc1; bf16_t* O2; int ldc2; int split_pn; int mode; const float* ssq_in; float* ssq_out; float* outf; PG8_LAS unsigned char* scr;
    template <int MODE>
    __device__ __forceinline__ void body(const f32x4 (&acc)[2][2][4][2], bf16_t* base, int ldc, int rowt, int colw, const float (&rs)[2][4], int pn, int wr, int wc, int fr, int fq) const {
        const int col0 = colw + 8 * fq;
        if (MODE == 3) {
            PG8_LAS unsigned char* wscr3 = scr + (wr * 4 + wc) * SCR_BYTES;
            const int lane3 = fr + 16 * fq, rr3 = lane3 >> 3, ch3 = lane3 & 7;
#pragma unroll
            for (int ai = 0; ai < 2; ++ai)
#pragma unroll
                for (int m = 0; m < 4; ++m) {
                    const int rowg = rowt + ai * HALF + wr * 64 + m * 16;
                    const u32x4 hl0 = *(const u32x4*)(base + (size_t)(rowg + rr3) * ldc + colw + 8 * ch3), hl1 = *(const u32x4*)(base + (size_t)(rowg + 8 + rr3) * ldc + colw + 8 * ch3);
                    *(PG8_LAS u32x4*)(wscr3 + rr3 * SCR_PITCH + ch3 * 16) = hl0; *(PG8_LAS u32x4*)(wscr3 + (rr3 + 8) * SCR_PITCH + ch3 * 16) = hl1;
                    u32x4 hb[2]; hb[0] = *(const PG8_LAS u32x4*)(wscr3 + fr * SCR_PITCH + fq * 16); hb[1] = *(const PG8_LAS u32x4*)(wscr3 + fr * SCR_PITCH + fq * 16 + 64);
#pragma unroll
                    for (int bj = 0; bj < 2; ++bj) {
                        const u32x4 h = hb[bj];
                        f32x4 v0 = acc[ai][bj][m][0] * rs[ai][m], v1 = acc[ai][bj][m][1] * rs[ai][m];
                        v0[0] += bflo(h.x); v0[1] += bfhi(h.x); v0[2] += bflo(h.y); v0[3] += bfhi(h.y);
                        v1[0] += bflo(h.z); v1[1] += bfhi(h.z); v1[2] += bflo(h.w); v1[3] += bfhi(h.w);
                        *(PG8_LAS f32x4*)(wscr3 + fr * SCR_PITCH + fq * 32) = v0; *(PG8_LAS f32x4*)(wscr3 + fr * SCR_PITCH + fq * 32 + 16) = v1;
                        const f32x4 o0 = *(const PG8_LAS f32x4*)(wscr3 + rr3 * SCR_PITCH + ch3 * 16), o1 = *(const PG8_LAS f32x4*)(wscr3 + (rr3 + 8) * SCR_PITCH + ch3 * 16);
                        float* op = outf + (size_t)(rowg + rr3) * ldc + colw + 32 * bj + 4 * ch3;
                        *(f32x4*)op = o0; *(f32x4*)(op + (size_t)8 * ldc) = o1;
                    }
                }
            return;
        }
        PG8_LAS unsigned char* wscr = scr + (wr * 4 + wc) * SCR_BYTES;
        PG8_LAS unsigned char* wp = wscr + fr * SCR_PITCH + fq * 16;
        const int lane = fr + 16 * fq, rr = lane >> 3, ch = lane & 7;
        const PG8_LAS unsigned char* rp = wscr + rr * SCR_PITCH + ch * 16;
#pragma unroll
        for (int ai = 0; ai < 2; ++ai) {
            u32x4 hl[4][2];
            if (MODE == 2) {
#pragma unroll
                for (int m = 0; m < 4; ++m)
#pragma unroll
                    for (int k = 0; k < 2; ++k) hl[m][k] = *(const u32x4*)(base + (size_t)(rowt + ai * HALF + wr * 64 + m * 16 + 8 * k + rr) * ldc + colw + 8 * ch);
            }
#pragma unroll
            for (int m = 0; m < 4; ++m) {
                const int rowg = rowt + ai * HALF + wr * 64 + m * 16;
                float ss = 0.f;
                u32x4 hb[2];
                if (MODE == 2) {
                    *(PG8_LAS u32x4*)(wscr + rr * SCR_PITCH + ch * 16) = hl[m][0]; *(PG8_LAS u32x4*)(wscr + (rr + 8) * SCR_PITCH + ch * 16) = hl[m][1];
                    hb[0] = *(const PG8_LAS u32x4*)wp; hb[1] = *(const PG8_LAS u32x4*)(wp + 64);
                }
#pragma unroll
                for (int bj = 0; bj < 2; ++bj) {
                    f32x4 v0 = acc[ai][bj][m][0], v1 = acc[ai][bj][m][1];
                    if (MODE == 0) { v0 = v0 * rs[ai][m]; v1 = v1 * rs[ai][m]; }
                    else if (MODE == 1) {
#pragma unroll
                        for (int e = 0; e < 4; ++e) { const float x = relu_f(v0[e]); v0[e] = x * x; const float y = relu_f(v1[e]); v1[e] = y * y; } }
                    else { const u32x4 h = hb[bj]; v0 = v0 * rs[ai][m]; v1 = v1 * rs[ai][m];
                        v0[0] += bflo(h.x); v0[1] += bfhi(h.x); v0[2] += bflo(h.y); v0[3] += bfhi(h.y);
                        v1[0] += bflo(h.z); v1[1] += bfhi(h.z); v1[2] += bflo(h.w); v1[3] += bfhi(h.w); }
                    u32x4 w; w.x = cvt_pk_bf16(v0[0], v0[1]); w.y = cvt_pk_bf16(v0[2], v0[3]); w.z = cvt_pk_bf16(v1[0], v1[1]); w.w = cvt_pk_bf16(v1[2], v1[3]);
                    if (MODE == 2) { const float r0 = bflo(w.x), r1 = bfhi(w.x), r2 = bflo(w.y), r3 = bfhi(w.y), r4 = bflo(w.z), r5 = bfhi(w.z), r6 = bflo(w.w), r7 = bfhi(w.w);
                        ss += ((r0 * r0 + r1 * r1) + (r2 * r2 + r3 * r3)) + ((r4 * r4 + r5 * r5) + (r6 * r6 + r7 * r7)); }
                    *(PG8_LAS u32x4*)(wp + 64 * bj) = w;
                }
                const u32x4 l0 = *(const PG8_LAS u32x4*)rp, l1 = *(const PG8_LAS u32x4*)(rp + 8 * SCR_PITCH);
                bf16_t* gp = base + (size_t)(rowg + rr) * ldc + colw + 8 * ch;
                st16(gp, l0); st16(gp + (size_t)8 * ldc, l1);
                if (MODE == 2) {
                    ss += __shfl_xor(ss, 16); ss += __shfl_xor(ss, 32);
                    if (fq == 0) ssq_out[(size_t)(rowg + fr) * 16 + pn * 4 + wc] = ss;
                }
            }
        }
    }
    __device__ __forceinline__ void operator()(const f32x4 (&acc)[2][2][4][2], const Unit& u, int wr, int wc, int fr, int fq) const {
        const int row0 = u.pm * BM + wr * 64 + fr;
        bf16_t* base = O1; int ldc = ldc1; int colt = u.pn * BM;
        if (u.pn >= split_pn) { base = O2; ldc = ldc2; colt = (u.pn - split_pn) * BM; }
        const int colw = colt + wc * 64;
        float rs[2][4];
        if (ssq_in) {
            const int lane = fr + 16 * fq, rq = lane >> 2, cq = lane & 3;
            f32x4 q[2][4];
#pragma unroll
            for (int ai = 0; ai < 2; ++ai)
#pragma unroll
                for (int m = 0; m < 4; ++m) q[ai][m] = *(const f32x4*)(ssq_in + (size_t)(u.pm * BM + ai * HALF + wr * 64 + m * 16 + rq) * 16 + 4 * cq);
#pragma unroll
            for (int ai = 0; ai < 2; ++ai)
#pragma unroll
                for (int m = 0; m < 4; ++m) { float t = (q[ai][m][0] + q[ai][m][1]) + (q[ai][m][2] + q[ai][m][3]); t += __shfl_xor(t, 1); t += __shfl_xor(t, 2);
                    const float tr = __shfl(t, 4 * fr);
                    const float r = __builtin_amdgcn_rsqf(tr * (1.0f / 1024.0f) + 1e-6f); rs[ai][m] = (mode >= 2) ? r * r : r; }
        } else {
#pragma unroll
            for (int ai = 0; ai < 2; ++ai)
#pragma unroll
                for (int m = 0; m < 4; ++m) rs[ai][m] = 1.0f;
        }
        const int rowt = u.pm * BM;
        if (mode == 1) body<1>(acc, base, ldc, rowt, colw, rs, u.pn, wr, wc, fr, fq);
        else if (mode == 0) body<0>(acc, base, ldc, rowt, colw, rs, u.pn, wr, wc, fr, fq);
        else if (mode == 2) body<2>(acc, base, ldc, rowt, colw, rs, u.pn, wr, wc, fr, fq);
        else body<3>(acc, base, ldc, rowt, colw, rs, u.pn, wr, wc, fr, fq);
    }
};

template <class Epi, class Sched, bool ALIGN_EPI = false, bool SP2 = false>
__device__ __forceinline__ void gemm_phase(PG8_LAS unsigned char* lds, const Gemm g, const Sched& S, const Epi& E) {
    int tid_ = threadIdx.x; asm volatile("" : "+v"(tid_));
    const int tid = tid_, wid = __builtin_amdgcn_readfirstlane(tid >> 6), lane = tid & 63, wr = wid >> 2, wc = wid & 3, fr = lane & 15, fq = lane >> 4;
    const int K = g.K, nt = K / BK;
    unsigned voffA[2], voffB[2];
#pragma unroll
    for (int i = 0; i < 2; ++i) { int R, C; stage_rc(tid * 16 + i * 8192, R, C); const int Rb = Epi::PERM ? (Epi::WIDE ? (64 * (R >> 5) + perm32(R & 31)) : ((R & ~31) + perm32(R & 31))) : R;
        voffA[i] = (unsigned)(R * K + C) * 2u; voffB[i] = (unsigned)(Rb * K + C) * 2u; }
    const size_t kstep = (size_t)(BK * 2);
    const size_t hstep = (size_t)HALF * K * 2;
    const size_t tstep = 2 * hstep;
    const size_t hstepB = (Epi::PERM && Epi::WIDE) ? (size_t)32 * K * 2 : hstep;
    const unsigned ldsw = (unsigned)wid * 1024u;
    const int aoff = lds_byte(wr * 64 + fr, fq * 8), boff = lds_byte(wc * 32 + fr, fq * 8);
#define PG8_SA(b, h) (((b) * 2 + (h)) * HTB)
#define PG8_SB(b, h) ((4 + (b) * 2 + (h)) * HTB)
#define PG8_STAGE(bufoff, gbase, voff) do { _Pragma("unroll") for (int _i = 0; _i < 2; ++_i) \
        __builtin_amdgcn_global_load_lds((const unsigned*)((const char*)(gbase) + (voff)[_i]), (PG8_LAS unsigned*)(lds + (bufoff) + ldsw + _i * 8192), 16, 0, 0); } while (0)
#define PG8_LDA(dst, b, h) do { _Pragma("unroll") for (int m = 0; m < 4; ++m) _Pragma("unroll") for (int k = 0; k < 2; ++k) dst[m][k] = *(const PG8_LAS bf16x8*)(lds + PG8_SA(b, h) + aoff + m * 2048 + k * 1024); } while (0)
#define PG8_LDB(dst, b, h) do { _Pragma("unroll") for (int n = 0; n < 2; ++n) _Pragma("unroll") for (int k = 0; k < 2; ++k) dst[n][k] = *(const PG8_LAS bf16x8*)(lds + PG8_SB(b, h) + boff + n * 2048 + k * 1024); } while (0)
#define PG8_MMA(ai, bj, At, Bt) do { __builtin_amdgcn_s_setprio(1); _Pragma("unroll") for (int m = 0; m < 4; ++m) _Pragma("unroll") for (int n = 0; n < 2; ++n) _Pragma("unroll") for (int k = 0; k < 2; ++k) \
        acc[ai][bj][m][n] = __builtin_amdgcn_mfma_f32_16x16x32_bf16(Bt[n][k], At[m][k], acc[ai][bj][m][n], 0, 0, 0); __builtin_amdgcn_s_setprio(0); } while (0)
#define PG8_WAIT_V(n) asm volatile("s_waitcnt vmcnt(" #n ")" ::: "memory")
#define PG8_WAIT_L(n) asm volatile("s_waitcnt lgkmcnt(" #n ")" ::: "memory")
#define PG8_BAR __builtin_amdgcn_s_barrier()
#define PG8_SCHED __builtin_amdgcn_sched_barrier(0)
    Unit cur, nxt; int ui = 0;
    if (!S.next(0, cur)) return;
    f32x4 acc[2][2][4][2];
#pragma unroll
    for (int a = 0; a < 2; ++a)
#pragma unroll
        for (int b = 0; b < 2; ++b)
#pragma unroll
            for (int m = 0; m < 4; ++m)
#pragma unroll
                for (int n = 0; n < 2; ++n) acc[a][b][m][n] = (f32x4){0.f, 0.f, 0.f, 0.f};
    bf16x8 At[4][2], B0[2][2], B1[2][2];
    const char* cA = (const char*)g.A + (size_t)cur.pm * tstep; const char* cB = (const char*)g.Bt + (size_t)cur.pn * tstep;
    S.a_ready(cur);
    if constexpr (SP2) {
        PG8_STAGE(PG8_SB(0, 0), cB, voffB); PG8_STAGE(PG8_SB(0, 1), cB + hstepB, voffB); PG8_STAGE(PG8_SA(0, 0), cA, voffA); PG8_STAGE(PG8_SA(0, 1), cA + hstep, voffA);
        if (wr == 1) PG8_BAR;
        PG8_WAIT_V(2); PG8_BAR;
        PG8_STAGE(PG8_SB(1, 0), cB + kstep, voffB); PG8_STAGE(PG8_SA(1, 0), cA + kstep, voffA); PG8_STAGE(PG8_SB(1, 1), cB + hstepB + kstep, voffB);
        PG8_WAIT_V(6); PG8_BAR;
    } else {
        PG8_STAGE(PG8_SB(0, 0), cB, voffB); PG8_STAGE(PG8_SA(0, 0), cA, voffA); PG8_STAGE(PG8_SB(0, 1), cB + hstepB, voffB); PG8_STAGE(PG8_SA(0, 1), cA + hstep, voffA);
        if (wr == 1) PG8_BAR;
        PG8_WAIT_V(4); PG8_BAR;
        PG8_STAGE(PG8_SB(1, 0), cB + kstep, voffB); PG8_STAGE(PG8_SA(1, 0), cA + kstep, voffA); PG8_STAGE(PG8_SB(1, 1), cB + hstepB + kstep, voffB);
        PG8_WAIT_V(6); PG8_BAR;
    }
    for (;;) {
        const bool has_next = S.next(ui + 1, nxt);
        const char* nA = has_next ? (const char*)g.A + (size_t)nxt.pm * tstep : cA; const char* nB = has_next ? (const char*)g.Bt + (size_t)nxt.pn * tstep : cB;
        for (int t = 0; t < nt; t += 2) {
            const bool last = (t == nt - 2);
            const char* a1 = cA + (size_t)(t + 1) * kstep;
            const char* a2 = last ? nA : cA + (size_t)(t + 2) * kstep; const char* b2 = last ? nB : cB + (size_t)(t + 2) * kstep;
            const char* a3 = a2 + kstep; const char* b3 = b2 + kstep;
            if (last && has_next) S.a_ready(nxt);
            if constexpr (SP2) {
            PG8_LDB(B0, 0, 0); PG8_LDB(B1, 0, 1); PG8_SCHED; PG8_LDA(At, 0, 0); PG8_STAGE(PG8_SA(1, 1), a1 + hstep, voffA);
            PG8_WAIT_V(8); PG8_WAIT_L(0); PG8_BAR; PG8_MMA(0, 0, At, B0); PG8_MMA(0, 1, At, B1); PG8_BAR; PG8_SCHED;
            PG8_LDA(At, 0, 1); PG8_STAGE(PG8_SB(0, 0), b2, voffB); PG8_STAGE(PG8_SB(0, 1), b2 + hstepB, voffB); PG8_STAGE(PG8_SA(0, 0), a2, voffA);
            PG8_WAIT_V(8); PG8_WAIT_L(0); PG8_BAR; PG8_MMA(1, 0, At, B0); PG8_MMA(1, 1, At, B1); PG8_BAR; PG8_SCHED;
            PG8_LDB(B0, 1, 0); PG8_LDB(B1, 1, 1); PG8_SCHED; PG8_LDA(At, 1, 0); PG8_STAGE(PG8_SA(0, 1), a2 + hstep, voffA);
            PG8_WAIT_V(8); PG8_WAIT_L(0); PG8_BAR; PG8_MMA(0, 0, At, B0); PG8_MMA(0, 1, At, B1); PG8_BAR; PG8_SCHED;
            PG8_LDA(At, 1, 1); PG8_STAGE(PG8_SB(1, 0), b3, voffB); PG8_STAGE(PG8_SB(1, 1), b3 + hstepB, voffB); PG8_STAGE(PG8_SA(1, 0), a3, voffA);
            PG8_WAIT_V(8); PG8_WAIT_L(0); PG8_BAR; PG8_MMA(1, 0, At, B0); PG8_MMA(1, 1, At, B1); PG8_BAR; PG8_SCHED;
            } else {
            PG8_LDB(B0, 0, 0); PG8_SCHED; PG8_LDA(At, 0, 0); PG8_STAGE(PG8_SA(1, 1), a1 + hstep, voffA);
            PG8_WAIT_L(8); PG8_BAR; PG8_WAIT_L(0); PG8_MMA(0, 0, At, B0); PG8_BAR; PG8_SCHED;
            PG8_LDB(B1, 0, 1); PG8_STAGE(PG8_SB(0, 0), b2, voffB);
            PG8_BAR; PG8_WAIT_L(0); PG8_MMA(0, 1, At, B1); PG8_BAR;
            PG8_LDA(At, 0, 1); PG8_STAGE(PG8_SA(0, 0), a2, voffA);
            PG8_BAR; PG8_WAIT_L(0); PG8_MMA(1, 0, At, B0); PG8_BAR; PG8_SCHED;
            PG8_STAGE(PG8_SB(0, 1), b2 + hstepB, voffB);
            PG8_WAIT_V(6); PG8_BAR; PG8_MMA(1, 1, At, B1); PG8_BAR;
            PG8_LDB(B0, 1, 0); PG8_SCHED; PG8_LDA(At, 1, 0); PG8_STAGE(PG8_SA(0, 1), a2 + hstep, voffA);
            PG8_WAIT_L(8); PG8_BAR; PG8_WAIT_L(0); PG8_MMA(0, 0, At, B0); PG8_BAR; PG8_SCHED;
            PG8_LDB(B1, 1, 1); PG8_STAGE(PG8_SB(1, 0), b3, voffB);
            PG8_BAR; PG8_WAIT_L(0); PG8_MMA(0, 1, At, B1); PG8_BAR;
            PG8_LDA(At, 1, 1); PG8_STAGE(PG8_SA(1, 0), a3, voffA);
            PG8_BAR; PG8_WAIT_L(0); PG8_MMA(1, 0, At, B0); PG8_BAR; PG8_SCHED;
            PG8_STAGE(PG8_SB(1, 1), b3 + hstepB, voffB);
            PG8_WAIT_V(6); PG8_BAR; PG8_MMA(1, 1, At, B1); PG8_BAR;
            }
        }
        if constexpr (ALIGN_EPI) { if (wr == 0) PG8_BAR; }
        if constexpr (!Epi::AFTER_DRAIN) { E(acc, cur, wr, wc, fr, fq); S.done(cur); }
        if (!has_next) break;
#pragma unroll
        for (int a = 0; a < 2; ++a)
#pragma unroll
            for (int b = 0; b < 2; ++b)
#pragma unroll
                for (int m = 0; m < 4; ++m)
#pragma unroll
                    for (int n = 0; n < 2; ++n) acc[a][b][m][n] = (f32x4){0.f, 0.f, 0.f, 0.f};
        cur = nxt; cA = nA; cB = nB; ++ui;
        if constexpr (ALIGN_EPI) { if (wr == 1) PG8_BAR; }
    }
    PG8_WAIT_V(0);
    if constexpr (!ALIGN_EPI) { if (wr == 0) PG8_BAR; }
    PG8_BAR;
    if constexpr (Epi::AFTER_DRAIN) { E.fused(acc, cur, wr, wc, fr, fq, lds, wid, lane); S.done(cur); }
#undef PG8_SA
#undef PG8_SB
#undef PG8_STAGE
#undef PG8_LDA
#undef PG8_LDB
#undef PG8_MMA
#undef PG8_WAIT_V
#undef PG8_WAIT_L
#undef PG8_BAR
#undef PG8_SCHED
}
}

constexpr int NWAVES = 8, NTHR = 512;
constexpr int DM = 1024, BATCH = 8, SEQ = 4096, DEPTH = 4, NA = 2;
constexpr int M = BATCH * SEQ;
constexpr int HD = 64, MEMLEN = 256, MAINW = 768, DFF = 4096;
constexpr int MROWS = BATCH * MEMLEN;
constexpr float EPS = 1e-6f;
constexpr float LOG2E = 1.4426950408889634f;

constexpr size_t MiB = 1u << 20;
constexpr size_t WS_WIN = 0;
constexpr size_t WS_WOUT = 12 * MiB;
constexpr size_t WS_WUP = 20 * MiB;
constexpr size_t WS_WDN = 52 * MiB;
constexpr size_t WS_WMKV = 84 * MiB;
constexpr size_t WS_WPOOL = 88 * MiB;
constexpr size_t WS_MEMN = 92 * MiB;
constexpr size_t WS_MKV = 96 * MiB;
constexpr size_t WS_KV = 104 * MiB;
constexpr size_t WS_XN = 136 * MiB;
constexpr size_t WS_BIG = 200 * MiB;
constexpr size_t WS_CTL = 456 * MiB;
constexpr size_t CTL_BYTES = 65536;
constexpr size_t WS_SSQ = 457 * MiB;
constexpr size_t WS_END = 461 * MiB;

constexpr int LDS_BYTES = 155648;
constexpr int EPI_SCR_OFF = 135168;
constexpr int MISC_OFF = 131072;

#define LAS __attribute__((address_space(3)))
typedef unsigned short bf16;
typedef unsigned v4u __attribute__((ext_vector_type(4)));
typedef unsigned v2u __attribute__((ext_vector_type(2)));
typedef float f32x4 __attribute__((ext_vector_type(4)));
typedef float f32x16 __attribute__((ext_vector_type(16)));
typedef short bf16x8 __attribute__((ext_vector_type(8)));
typedef short s16x4 __attribute__((ext_vector_type(4)));
#define LDS_WAIT() asm volatile("s_waitcnt lgkmcnt(0)" ::: "memory")
__device__ __forceinline__ unsigned pk2(float lo, float hi) { return pg8::cvt_pk_bf16(lo, hi); }
__device__ __forceinline__ float bf_lo(unsigned u) { return __uint_as_float(u << 16); }
__device__ __forceinline__ float bf_hi(unsigned u) { return __uint_as_float(u & 0xffff0000u); }
__device__ __forceinline__ void unpack8(const v4u r, float* f) { f[0] = bf_lo(r.x); f[1] = bf_hi(r.x); f[2] = bf_lo(r.y); f[3] = bf_hi(r.y); f[4] = bf_lo(r.z); f[5] = bf_hi(r.z); f[6] = bf_lo(r.w); f[7] = bf_hi(r.w); }
__device__ __forceinline__ v4u pack8(const float* f) { v4u o; o.x = pk2(f[0], f[1]); o.y = pk2(f[2], f[3]); o.z = pk2(f[4], f[5]); o.w = pk2(f[6], f[7]); return o; }
__device__ __forceinline__ float wave_sum(float v) {
#pragma unroll
    for (int o = 1; o < 64; o <<= 1) v += __shfl_xor(v, o);
    return v;
}
#define XB_TMO      128
#define XB_XCNT(j)  (256  + 64 * (j))
#define XB_XSUB(j)  (1280 + 64 * (j))
#define XB_XGEN(j)  (2304 + 64 * (j))
#define XB_TOP      3328
#define XB_TOPGEN   3392
#define XCD_BAR_WORDS 3456
#define XB_SPIN_CAP (1u << 18)

__device__ __forceinline__ unsigned xb_ld(unsigned* p)              { return __hip_atomic_load(p, __ATOMIC_RELAXED, __HIP_MEMORY_SCOPE_AGENT); }
__device__ __forceinline__ unsigned xb_add(unsigned* p, unsigned v) { return __hip_atomic_fetch_add(p, v, __ATOMIC_RELAXED, __HIP_MEMORY_SCOPE_AGENT); }
__device__ __forceinline__ unsigned xb_xcc_id() { return (unsigned)__builtin_amdgcn_s_getreg((3 << 11) | 20) & 0xFu; }
#define XB_SPIN(cond, bar) do { unsigned _sp = 0; while (cond) { __builtin_amdgcn_s_sleep(1); \
    if ((++_sp & 255u) == 0u) { if (xb_ld(&(bar)[XB_TMO])) break; if (_sp > XB_SPIN_CAP) { atomicAdd(&(bar)[XB_TMO], 1u); break; } } } } while (0)

struct XcdBarrier {
    unsigned* bar; unsigned x;
    volatile LAS unsigned* st;
};

__device__ __forceinline__ XcdBarrier xcd_barrier_post(unsigned* bar, volatile LAS unsigned* st) {
    XcdBarrier b; b.bar = bar; b.x = xb_xcc_id(); b.st = st;
    if (threadIdx.x == 0) (void)xb_add(&bar[XB_XCNT(b.x)], 1u);
    return b;
}
__device__ __forceinline__ void xcd_barrier_complete(unsigned* bar, unsigned x, unsigned& nloc, unsigned& nx) {
    const unsigned G = gridDim.x * gridDim.y * gridDim.z;
    unsigned sum, cnt, mine, sp = 0u;
    for (;;) {
        sum = 0u; cnt = 0u; mine = 0u;
#pragma unroll
        for (unsigned j = 0; j < 16; ++j) { const unsigned c = xb_ld(&bar[XB_XCNT(j)]); sum += c; cnt += (c > 0u) ? 1u : 0u; mine = (j == x) ? c : mine; }
        if (sum == G) break;
        __builtin_amdgcn_s_sleep(1);
        if ((++sp & 255u) == 0u) { if (xb_ld(&bar[XB_TMO])) break; if (sp > XB_SPIN_CAP) { atomicAdd(&bar[XB_TMO], 1u); break; } }
    }
    nloc = mine > 0u ? mine : 1u; nx = cnt > 0u ? cnt : 1u;
}

__device__ __forceinline__ void xcd_barrier(const XcdBarrier& b) {
    asm volatile("s_waitcnt vmcnt(0)" ::: "memory");
    __syncthreads();
    if (threadIdx.x == 0) {
        unsigned* bar = b.bar;
        __builtin_amdgcn_s_waitcnt(0);
        unsigned nloc = b.st[0], nx = b.st[1];
        if (nloc == 0u) { xcd_barrier_complete(bar, b.x, nloc, nx); b.st[0] = nloc; b.st[1] = nx; }
        const unsigned old = xb_add(&bar[XB_XSUB(b.x)], 1u);
        const unsigned gen = old / nloc;
        if (old + 1u == (gen + 1u) * nloc) {
            __builtin_amdgcn_fence(__ATOMIC_RELEASE, "agent");
            asm volatile("s_waitcnt vmcnt(0)" ::: "memory");
            const unsigned og = xb_add(&bar[XB_TOP], 1u);
            const unsigned tg = og / nx;
            if (og + 1u == (tg + 1u) * nx) xb_add(&bar[XB_TOPGEN], 1u);
            else XB_SPIN(xb_ld(&bar[XB_TOPGEN]) == tg, bar);
            __builtin_amdgcn_fence(__ATOMIC_ACQUIRE, "agent");
            xb_add(&bar[XB_XGEN(b.x)], 1u);
            asm volatile("s_waitcnt vmcnt(0)" ::: "memory");
        } else {
            XB_SPIN(xb_ld(&bar[XB_XGEN(b.x)]) == gen, bar);
            __builtin_amdgcn_fence(__ATOMIC_ACQUIRE, "agent");
            asm volatile("s_waitcnt vmcnt(0)" ::: "memory");
        }
    }
    __syncthreads();
}

namespace att {
constexpr int KP = 144;
constexpr int OS_PITCH = 144, OS_BYTES = 32 * OS_PITCH;
__device__ __forceinline__ int crow(int r, int hi) { return (r & 3) + 8 * (r >> 2) + 4 * hi; }

struct StageRegs { v4u kr[6], va[3], vb[3]; };
template <int NKEYS>
__device__ __forceinline__ void stage_load(StageRegs& R, const bf16* ksrc, const bf16* vsrc, int pitch, int first_valid, int tid) {
    constexpr int NK = NKEYS * 8 / NTHR, NV = NKEYS * 4 / NTHR;
    const int c = tid & 7, r0 = tid >> 3;
#pragma unroll
    for (int it = 0; it < NK; ++it) { const int row = r0 + it * (NTHR / 8); R.kr[it] = (v4u){0u, 0u, 0u, 0u}; if (row >= first_valid) R.kr[it] = *(const v4u*)(ksrc + (long)row * pitch + 8 * c); }
#pragma unroll
    for (int it = 0; it < NV; ++it) { const int kp = r0 + it * (NTHR / 8); R.va[it] = (v4u){0u, 0u, 0u, 0u}; R.vb[it] = R.va[it];
        if (2 * kp >= first_valid) { R.va[it] = *(const v4u*)(vsrc + (long)(2 * kp) * pitch + 8 * c); R.vb[it] = *(const v4u*)(vsrc + (long)(2 * kp + 1) * pitch + 8 * c); } }
#pragma unroll
    for (int it = NK; it < 6; ++it) R.kr[it] = (v4u){0u, 0u, 0u, 0u};
#pragma unroll
    for (int it = NV; it < 3; ++it) { R.va[it] = (v4u){0u, 0u, 0u, 0u}; R.vb[it] = (v4u){0u, 0u, 0u, 0u}; }
}
template <int NKEYS, int VP>
__device__ __forceinline__ void stage_write(const StageRegs& R, LAS unsigned char* Kl, LAS unsigned char* Vt, const float* gain, int tid) {
    constexpr int NK = NKEYS * 8 / NTHR, NV = NKEYS * 4 / NTHR;
    const int c = tid & 7, r0 = tid >> 3;
    float g[8];
#pragma unroll
    for (int i = 0; i < 8; ++i) g[i] = gain[8 * c + i];
#pragma unroll
    for (int it = 0; it < NK; ++it) {
        const int row = r0 + it * (NTHR / 8);
        float f[8]; unpack8(R.kr[it], f);
        float ss = 0.f;
#pragma unroll
        for (int i = 0; i < 8; ++i) ss += f[i] * f[i];
        ss += __shfl_xor(ss, 1); ss += __shfl_xor(ss, 2); ss += __shfl_xor(ss, 4);
        const float rstd = __builtin_amdgcn_rsqf(ss * (1.0f / 64.0f) + EPS);
#pragma unroll
        for (int i = 0; i < 8; ++i) f[i] = f[i] * rstd * g[i];
        *(LAS v4u*)(Kl + row * KP + 16 * c) = pack8(f);
    }
#pragma unroll
    for (int it = 0; it < NV; ++it) {
        const int kp = r0 + it * (NTHR / 8);
        const v4u a = R.va[it], b = R.vb[it];
        const int q = (2 * kp) & 15, pos = ((q >> 2) & 1) * 8 + (q >> 3) * 4 + (q & 3);
        LAS unsigned char* p = Vt + (8 * c) * VP + 2 * (((2 * kp) & ~15) + pos);
        *(LAS unsigned*)(p + 0 * VP) = (a.x & 0xffffu) | (b.x << 16);
        *(LAS unsigned*)(p + 1 * VP) = (a.x >> 16) | (b.x & 0xffff0000u);
        *(LAS unsigned*)(p + 2 * VP) = (a.y & 0xffffu) | (b.y << 16);
        *(LAS unsigned*)(p + 3 * VP) = (a.y >> 16) | (b.y & 0xffff0000u);
        *(LAS unsigned*)(p + 4 * VP) = (a.z & 0xffffu) | (b.z << 16);
        *(LAS unsigned*)(p + 5 * VP) = (a.z >> 16) | (b.z & 0xffff0000u);
        *(LAS unsigned*)(p + 6 * VP) = (a.w & 0xffffu) | (b.w << 16);
        *(LAS unsigned*)(p + 7 * VP) = (a.w >> 16) | (b.w & 0xffff0000u);
    }
}
struct QRaw { v4u r[4]; };
__device__ __forceinline__ void q_load(QRaw& q, const bf16* Q, int qpitch, int lane) {
    const bf16* qp = Q + (long)(lane & 31) * qpitch + 8 * (lane >> 5);
#pragma unroll
    for (int s = 0; s < 4; ++s) q.r[s] = *(const v4u*)(qp + 16 * s);
}
struct QLine { v4u r[4]; };
__device__ __forceinline__ void q_load_lines(QLine& q, const bf16* Q, int qpitch, int lane) {
    const bf16* qp = Q + (long)(lane >> 3) * qpitch + 8 * (lane & 7);
#pragma unroll
    for (int k = 0; k < 4; ++k) q.r[k] = *(const v4u*)(qp + (long)(8 * k) * qpitch);
}
__device__ __forceinline__ void q_redistribute(const QLine& ql, QRaw& q, LAS unsigned char* stage, int lane) {
#pragma unroll
    for (int k = 0; k < 4; ++k) *(LAS v4u*)(stage + (8 * k + (lane >> 3)) * OS_PITCH + 16 * (lane & 7)) = ql.r[k];
#pragma unroll
    for (int s = 0; s < 4; ++s) q.r[s] = *(const LAS v4u*)(stage + (lane & 31) * OS_PITCH + (2 * s + (lane >> 5)) * 16);
}
__device__ __forceinline__ void q_gains(const float* gq, int lane, f32x4 (&gv)[8]) {
#pragma unroll
    for (int s = 0; s < 4; ++s) { gv[2 * s] = *(const f32x4*)(gq + 16 * s + 8 * (lane >> 5)); gv[2 * s + 1] = *(const f32x4*)(gq + 16 * s + 8 * (lane >> 5) + 4); }
}
__device__ __forceinline__ void q_norm(const QRaw& q, const f32x4 (&gv)[8], int lane, bf16x8 (&qf)[4]) {
    float f[4][8]; float ss = 0.f;
#pragma unroll
    for (int s = 0; s < 4; ++s) { unpack8(q.r[s], f[s]);
#pragma unroll
        for (int j = 0; j < 8; ++j) ss += f[s][j] * f[s][j]; }
    ss += __shfl_xor(ss, 32);
    const float rstd = (0.125f * LOG2E) * __builtin_amdgcn_rsqf(ss * (1.0f / 64.0f) + EPS);
#pragma unroll
    for (int s = 0; s < 4; ++s) {
#pragma unroll
        for (int j = 0; j < 8; ++j) f[s][j] = f[s][j] * rstd * gv[2 * s + (j >> 2)][j & 3];
        qf[s] = __builtin_bit_cast(bf16x8, pack8(f[s]));
    }
}
__device__ __forceinline__ float score_bound2(const float* gq, const float* gk, int lane) {
    float a = fabsf(gq[lane]), b = fabsf(gk[lane]);
#pragma unroll
    for (int o = 1; o < 64; o <<= 1) { a = fmaxf(a, __shfl_xor(a, o)); b = fmaxf(b, __shfl_xor(b, o)); }
    return 8.1f * a * b * LOG2E;
}
template <int NKT, bool SWA, int VP, int NH>
__device__ __forceinline__ void task(LAS const unsigned char* Kl, LAS const unsigned char* Vt, const bf16x8 (&qf)[NH][4],
                                     bf16* const (&O)[NH], int opitch, const float (&slope2)[NH], const float (&sink2)[NH], const float (&shift2)[NH], int kt_first, int lane, LAS unsigned char* oscr) {
    const int ql = lane & 31, hi = lane >> 5;
    int qh = ql - 4 * hi; asm volatile("" : "+v"(qh));
    float base[NH];
#pragma unroll
    for (int h = 0; h < NH; ++h) { base[h] = -shift2[h]; if (SWA) base[h] -= slope2[h] * (float)(qh + 128); }
    const short one = (ql == 0) ? (short)0x3F80 : (short)0;
    const bf16x8 onesf = (bf16x8){one, one, one, one, one, one, one, one};
    constexpr bool ONES = (NH == 1);
    f32x16 Oa[NH][ONES ? 3 : 2]; float vsum[NH];
#pragma unroll
    for (int h = 0; h < NH; ++h) { vsum[h] = 0.f; Oa[h][0] = (f32x16){0.f, 0.f, 0.f, 0.f, 0.f, 0.f, 0.f, 0.f, 0.f, 0.f, 0.f, 0.f, 0.f, 0.f, 0.f, 0.f}; Oa[h][1] = Oa[h][0]; if (ONES) Oa[h][ONES ? 2 : 0] = Oa[h][0]; }
#pragma unroll
    for (int kt = 0; kt < NKT; ++kt) {
        if (SWA && kt < kt_first) continue;
        f32x16 S[NH];
#pragma unroll
        for (int h = 0; h < NH; ++h)
#pragma unroll
            for (int r = 0; r < 16; ++r) {
                const int cr = (r & 3) + 8 * (r >> 2);
                float c = base[h];
                if (SWA) {
                    c = fmaf(slope2[h], (float)(32 * kt + cr), base[h]);
                    if (kt == 0) c = (cr > qh) ? c : -1e30f;
                    if (kt == NKT - 1) c = (cr <= qh) ? c : -1e30f;
                }
                S[h][r] = c;
            }
#pragma unroll
        for (int s = 0; s < 4; ++s) {
            const bf16x8 kf = *(LAS const bf16x8*)(Kl + (32 * kt + ql) * KP + (16 * s + 8 * hi) * 2);
#pragma unroll
            for (int h = 0; h < NH; ++h) S[h] = __builtin_amdgcn_mfma_f32_32x32x16_bf16(kf, qf[h][s], S[h], 0, 0, 0);
        }
#pragma unroll
        for (int h = 0; h < NH; ++h)
#pragma unroll
            for (int r = 0; r < 16; ++r) { S[h][r] = __builtin_amdgcn_exp2f(S[h][r]); if (!ONES) vsum[h] += S[h][r]; }
#pragma unroll
        for (int s = 0; s < 2; ++s) {
            bf16x8 pf[NH];
#pragma unroll
            for (int h = 0; h < NH; ++h) { v4u pw; pw.x = pk2(S[h][8 * s + 0], S[h][8 * s + 1]); pw.y = pk2(S[h][8 * s + 2], S[h][8 * s + 3]);
                pw.z = pk2(S[h][8 * s + 4], S[h][8 * s + 5]); pw.w = pk2(S[h][8 * s + 6], S[h][8 * s + 7]); pf[h] = __builtin_bit_cast(bf16x8, pw); }
#pragma unroll
            for (int dt = 0; dt < 2; ++dt) {
                const bf16x8 vf = *(LAS const bf16x8*)(Vt + (32 * dt + ql) * VP + (32 * kt + 16 * s) * 2 + 16 * hi);
#pragma unroll
                for (int h = 0; h < NH; ++h) Oa[h][dt] = __builtin_amdgcn_mfma_f32_32x32x16_bf16(vf, pf[h], Oa[h][dt], 0, 0, 0);
            }
            if (ONES)
#pragma unroll
                for (int h = 0; h < NH; ++h) Oa[h][ONES ? 2 : 0] = __builtin_amdgcn_mfma_f32_32x32x16_bf16(onesf, pf[h], Oa[h][ONES ? 2 : 0], 0, 0, 0);
        }
        __builtin_amdgcn_sched_barrier(0);
    }
#pragma unroll
    for (int h = 0; h < NH; ++h) {
        float sum = ONES ? Oa[h][ONES ? 2 : 0][0] : vsum[h]; sum += __shfl_xor(sum, 32);
        if (SWA) sum += __builtin_amdgcn_exp2f(sink2[h] - shift2[h]);
        const float inv = 1.0f / sum;
        LAS unsigned char* so = oscr + ql * OS_PITCH + 8 * hi;
#pragma unroll
        for (int dt = 0; dt < 2; ++dt)
#pragma unroll
            for (int rg = 0; rg < 4; ++rg) {
                v2u w; w.x = pk2(Oa[h][dt][4 * rg + 0] * inv, Oa[h][dt][4 * rg + 1] * inv); w.y = pk2(Oa[h][dt][4 * rg + 2] * inv, Oa[h][dt][4 * rg + 3] * inv);
                *(LAS v2u*)(so + 64 * dt + 16 * rg) = w;
            }
        const int rr = lane >> 3, ch = lane & 7;
#pragma unroll
        for (int k = 0; k < 4; ++k) {
            const v4u l = *(const LAS v4u*)(oscr + (8 * k + rr) * OS_PITCH + 16 * ch);
            *(v4u*)(O[h] + (long)(8 * k + rr) * opitch + 8 * ch) = l;
        }
    }
}
constexpr int SWA_VP = 784, MEM_VP = 528;
__device__ __forceinline__ LAS unsigned char* out_stage(LAS unsigned char* lds, int wave) { return lds + ((wave < 5) ? (105472 + wave * OS_BYTES) : (131328 + (wave - 5) * OS_BYTES)); }
constexpr int SWA_VT_OFF = 384 * KP, MEM_VT_OFF = 256 * KP;
}

struct Args { const float* in[19]; float* out; unsigned char* ws; int ph_lo, ph_hi; };

struct MixP { const bf16* PROJ; const bf16* KV; const bf16* MKV; bf16* CAT; const float *knorm, *qnorm, *sinks, *mknorm, *mqnorm; int l; };
__device__ __forceinline__ void unit_load(const MixP& P, int v, int tid, int wave, att::StageRegs& R) {
    asm volatile("" : "+v"(tid));
    const int lane = tid & 63;
    if (v < 512) {
        const int b = v & 7, rem = v >> 3, kvh = rem >> 4, tb = rem & 15;     const long t0 = (long)b * SEQ + tb * 256;
        att::stage_load<384>(R, P.KV + (t0 - 128) * 512 + kvh * 64, P.KV + (t0 - 128) * 512 + 256 + kvh * 64, 512, (tb == 0) ? 128 : 0, tid);
    } else {
        const int u = v - 512, b = u & 7, rem = u >> 3, h = rem >> 3, tb = rem & 7; const long t0 = (long)b * SEQ + tb * 512;
        const bf16* ksrc = P.MKV + (long)(b * MEMLEN) * 2048 + P.l * 512 + h * 64;
        att::stage_load<256>(R, ksrc, ksrc + 256, 2048, 0, tid);
    }
}
__device__ __forceinline__ void unit_write(const MixP& P, int v, LAS unsigned char* lds, int tid, const att::StageRegs& R) {
    asm volatile("" : "+v"(tid));
    if (v < 512) att::stage_write<384, att::SWA_VP>(R, lds, lds + att::SWA_VT_OFF, P.knorm, tid);
    else att::stage_write<256, att::MEM_VP>(R, lds, lds + att::MEM_VT_OFF, P.mknorm + P.l * 64, tid);
}
__device__ __forceinline__ void unit_tasks(const MixP& P, int v, LAS unsigned char* lds, int tid, int wave) {
    asm volatile("" : "+v"(tid));
    const int lane = tid & 63;
    if (v < 512) {
        const int j = P.l - NA;
        const int b = v & 7, rem = v >> 3, kvh = rem >> 4, tb = rem & 15;     const long t0 = (long)b * SEQ + tb * 256;
        const int i = wave;
        att::QLine qcur; att::q_load_lines(qcur, P.PROJ + (t0 + 32 * i) * 1024 + (kvh * 3) * 64, 1024, lane);
        LAS unsigned char* const stage = att::out_stage(lds, wave);
        f32x4 gv[8]; att::q_gains(P.qnorm + j * 64, lane, gv);
        float sk3[3];
#pragma unroll
        for (int g = 0; g < 3; ++g) sk3[g] = P.sinks[j * 12 + kvh * 3 + g];
        const float bound2 = att::score_bound2(P.qnorm + j * 64, P.knorm, lane);
        LAS unsigned char* Kl = lds; LAS unsigned char* Vt = lds + att::SWA_VT_OFF;
        const int kt_first = (tb == 0) ? ((4 - i) > 0 ? (4 - i) : 0) : 0;
#pragma unroll 1
        for (int g = 0; g < 3; ++g) {
            const int hq = kvh * 3 + g;
            int ln = lane; asm volatile("" : "+v"(ln));
            att::QLine qn = qcur;
            if (g < 2) att::q_load_lines(qn, P.PROJ + (t0 + 32 * i) * 1024 + (hq + 1) * 64, 1024, ln);
            att::QRaw qr; att::q_redistribute(qcur, qr, stage, ln);
            bf16x8 qf[1][4]; att::q_norm(qr, gv, ln, qf[0]);
            const float slope2 = exp2f(-8.0f * (float)(hq + 1) / 12.0f) * LOG2E;
            const float sink2 = ((g == 0) ? sk3[0] : (g == 1) ? sk3[1] : sk3[2]) * LOG2E;
            const float shift2 = fmaxf(bound2, sink2);
            bf16* const O1[1] = {P.CAT + (t0 + 32 * i) * 1024 + hq * 64}; const float sl1[1] = {slope2}, sk1[1] = {sink2}, sh1[1] = {shift2};
            att::task<5, true, att::SWA_VP, 1>(Kl + 32 * i * att::KP, Vt + 32 * i * 2, qf, O1, 1024, sl1, sk1, sh1, kt_first, ln, stage);
            qcur = qn;
        }
    } else {
        const int u = v - 512, b = u & 7, rem = u >> 3, h = rem >> 3, tb = rem & 7; const long t0 = (long)b * SEQ + tb * 512;
        att::QLine ql0, ql1;
        att::q_load_lines(ql0, P.PROJ + (t0 + 32 * wave) * 1024 + MAINW + h * 64, 1024, lane);
        att::q_load_lines(ql1, P.PROJ + (t0 + 32 * (wave + 8)) * 1024 + MAINW + h * 64, 1024, lane);
        LAS unsigned char* const stage = att::out_stage(lds, wave);
        f32x4 gv[8]; att::q_gains(P.mqnorm + P.l * 64, lane, gv);
        const float bound2 = att::score_bound2(P.mqnorm + P.l * 64, P.mknorm + P.l * 64, lane);
        LAS unsigned char* Kl = lds; LAS unsigned char* Vt = lds + att::MEM_VT_OFF;
        int ln = lane; asm volatile("" : "+v"(ln));
        att::QRaw q0, q1; att::q_redistribute(ql0, q0, stage, ln); att::q_redistribute(ql1, q1, stage, ln);
        bf16x8 qf[2][4]; att::q_norm(q0, gv, ln, qf[0]); att::q_norm(q1, gv, ln, qf[1]);
        bf16* const cat = P.CAT + (t0 + 32 * wave) * 1024 + MAINW + h * 64;
        bf16* const O2[2] = {cat, cat + (long)256 * 1024};
        const float z2[2] = {0.f, 0.f}, sh2[2] = {bound2, bound2};
        att::task<8, false, att::MEM_VP, 2>(Kl, Vt, qf, O2, 1024, z2, z2, sh2, 0, ln, stage);
    }
}
template <int W>
__device__ __forceinline__ void pool_run(const bf16* up, bf16* dp, int tin) {
    constexpr int RUN = 32;
    v4u ring[W]; float s[8];
#pragma unroll
    for (int i = 0; i < 8; ++i) s[i] = 0.f;
#pragma unroll
    for (int k = 0; k < W; ++k) { ring[k] = (v4u){0u, 0u, 0u, 0u}; if (tin > 0) ring[k] = *(const v4u*)(up - (long)(W - k) * 1024); }
#pragma unroll
    for (int k = 0; k < W; ++k) { float f[8]; unpack8(ring[k], f);
#pragma unroll
        for (int i = 0; i < 8; ++i) s[i] += f[i]; }
#pragma unroll
    for (int tb = 0; tb < RUN; tb += 8) {
        v4u xr[8];
#pragma unroll
        for (int j = 0; j < 8; ++j) xr[j] = *(const v4u*)(up + (long)(tb + j) * 1024);
#pragma unroll
        for (int j = 0; j < 8; ++j) {
            const int t = tb + j;
            float x[8], p[8]; unpack8(xr[j], x); unpack8(ring[t % W], p);
            ring[t % W] = xr[j];
            const float rc = (tin > 0 || t + 1 >= W) ? (1.0f / (float)W) : (1.0f / (float)(t + 1));
            float d[8];
#pragma unroll
            for (int i = 0; i < 8; ++i) { s[i] += x[i] - p[i]; d[i] = s[i] * rc - x[i]; }
            *(v4u*)(dp + (long)t * 1024) = pack8(d);
        }
        asm volatile("" ::: "memory");
    }
}
__device__ __forceinline__ void pool_pass(const bf16* PROJ, bf16* DOUT, int bx, int G, int wave, int lane) {
    if (wave >= 6) return;
    for (int wi = bx * 6 + wave; wi < 4 * 3 * 128; wi += G * 6) {
        int g = wi / 384, rem = wi - g * 384, cb = rem >> 7, rb = rem & 127;
        if (G == 256) {
            const int k = (bx >> 3) * 6 + wave; g = k / 48; const int r2 = k - g * 48; cb = r2 >> 4; rb = (bx & 7) * 16 + (r2 & 15);
        }
        const int run = rb * 8 + (lane >> 3), c = g * 24 + cb * 8 + (lane & 7);
        const long t0 = (long)run * 32; const int tin = (int)(t0 & (SEQ - 1));
        const bf16* up = PROJ + t0 * 1024 + 8 * c; bf16* dp = DOUT + t0 * 1024 + 8 * c;
        if (g == 0) pool_run<2>(up, dp, tin); else if (g == 1) pool_run<4>(up, dp, tin); else if (g == 2) pool_run<8>(up, dp, tin); else pool_run<16>(up, dp, tin);
    }
}

enum { I_X = 0, I_MEM, I_NORM_MIX, I_W_IN, I_POOL_W, I_POOL_SCALE, I_KV_NORM, I_W_KV, I_K_NORM, I_Q_NORM, I_SINKS, I_MEM_NORM, I_W_MEM_KV,
       I_MEM_Q_NORM, I_MEM_K_NORM, I_W_OUT, I_NORM_MLP, I_W_UP, I_W_DOWN };

constexpr int NTR = 2048 + 2048 + 8192 + 8192 + 1024 + 256;
constexpr size_t WS_TMPA = WS_BIG + 128 * MiB, WS_PP = WS_BIG + 136 * MiB;
struct TrD { const float* W; bf16* WT; const float* gk; int ldw, ldt; };
__device__ __forceinline__ void tr_load(const TrD& d, f32x4 (&v)[8], int lane) {
#pragma unroll
    for (int i = 0; i < 8; ++i) v[i] = *(const f32x4*)(d.W + (size_t)(8 * i + (lane >> 3)) * d.ldw + 4 * (lane & 7));
}
__device__ __forceinline__ void tr_store(const TrD& d, const f32x4 (&v)[8], LAS float* scr, int lane) {
#pragma unroll
    for (int i = 0; i < 8; ++i) { LAS float* p = scr + (8 * i + (lane >> 3)) * 33 + 4 * (lane & 7); p[0] = v[i][0]; p[1] = v[i][1]; p[2] = v[i][2]; p[3] = v[i][3]; }
    LDS_WAIT(); asm volatile("" ::: "memory");
    const int c = lane & 7;
    f32x4 g0 = (f32x4){1.f, 1.f, 1.f, 1.f}, g1 = g0;
    if (d.gk) { g0 = *(const f32x4*)(d.gk + 8 * c); g1 = *(const f32x4*)(d.gk + 8 * c + 4); }
#pragma unroll
    for (int j = 0; j < 4; ++j) { const int n = (lane >> 3) + 8 * j; const LAS float* s = scr + (8 * c) * 33 + n;
        v4u o; o.x = pk2(s[0 * 33] * g0[0], s[1 * 33] * g0[1]); o.y = pk2(s[2 * 33] * g0[2], s[3 * 33] * g0[3]); o.z = pk2(s[4 * 33] * g1[0], s[5 * 33] * g1[1]); o.w = pk2(s[6 * 33] * g1[2], s[7 * 33] * g1[3]);
        *(v4u*)(d.WT + (size_t)n * d.ldt + 8 * c) = o; }
    LDS_WAIT(); asm volatile("" ::: "memory");
}
__device__ __forceinline__ void rms_row(const float* xrow, bf16* orow, int lane) {
    const f32x4* xr = (const f32x4*)xrow + lane;
    f32x4 v[4]; float s = 0.f;
#pragma unroll
    for (int j = 0; j < 4; ++j) { v[j] = xr[64 * j]; s += (v[j].x * v[j].x + v[j].y * v[j].y) + (v[j].z * v[j].z + v[j].w * v[j].w); }
    const float rstd = 1.0f / sqrtf(wave_sum(s) * (1.0f / DM) + EPS);
    unsigned long long* o8 = (unsigned long long*)orow + lane;
#pragma unroll
    for (int j = 0; j < 4; ++j) o8[64 * j] = (unsigned long long)pk2(v[j].x * rstd, v[j].y * rstd) | ((unsigned long long)pk2(v[j].z * rstd, v[j].w * rstd) << 32);
}
struct XRows { f32x4 v[2][4]; };
__device__ __forceinline__ void xrows_load(XRows& x, const float* x0, const float* x1, int lane) {
    const f32x4* pa = (const f32x4*)x0 + 2 * lane; const f32x4* pb = (const f32x4*)x1 + 2 * lane;
#pragma unroll
    for (int j = 0; j < 2; ++j) { x.v[0][2 * j] = pa[128 * j]; x.v[0][2 * j + 1] = pa[128 * j + 1]; x.v[1][2 * j] = pb[128 * j]; x.v[1][2 * j + 1] = pb[128 * j + 1]; }
}
__device__ __forceinline__ void xrows_store(const XRows& x, bf16* o0, bf16* o1, float* q0, float* q1, int lane) {
    float ss[2];
#pragma unroll
    for (int r = 0; r < 2; ++r) {
        v4u* op = (v4u*)(r == 0 ? o0 : o1) + lane; float s = 0.f;
#pragma unroll
        for (int j = 0; j < 2; ++j) {
            const f32x4 a = x.v[r][2 * j], b = x.v[r][2 * j + 1];
            v4u w; w.x = pk2(a.x, a.y); w.y = pk2(a.z, a.w); w.z = pk2(b.x, b.y); w.w = pk2(b.z, b.w);
            const float r0 = bf_lo(w.x), r1 = bf_hi(w.x), r2 = bf_lo(w.y), r3 = bf_hi(w.y), r4 = bf_lo(w.z), r5 = bf_hi(w.z), r6 = bf_lo(w.w), r7 = bf_hi(w.w);
            s += ((r0 * r0 + r1 * r1) + (r2 * r2 + r3 * r3)) + ((r4 * r4 + r5 * r5) + (r6 * r6 + r7 * r7));
            op[64 * j] = w;
        }
        ss[r] = wave_sum(s);
    }
    if (lane < 16) { q0[lane] = (lane == 0) ? ss[0] : 0.f; q1[lane] = (lane == 0) ? ss[1] : 0.f; }
}
__device__ __forceinline__ void fold_item(const float* P, const float* scale, const float* Wo, bf16* WT, int item, int lane) {
    const int c0 = (item >> 4) * 8, n = (item & 15) * 64 + lane;
    float acc[8];
#pragma unroll
    for (int j = 0; j < 8; ++j) acc[j] = 0.f;
    for (int d = 0; d < 192; d += 4) {
        const f32x4 sc = *(const f32x4*)(scale + d);
        float w[4];
#pragma unroll
        for (int e = 0; e < 4; ++e) w[e] = Wo[(size_t)(d + e) * DM + n] * sc[e];
#pragma unroll
        for (int j = 0; j < 8; ++j) { const f32x4 p = *(const f32x4*)(P + (c0 + j) * 192 + d); acc[j] += (p[0] * w[0] + p[1] * w[1]) + (p[2] * w[2] + p[3] * w[3]); }
    }
    *(v4u*)(WT + (size_t)n * DM + c0) = pack8(acc);
}

__device__ __forceinline__ void tr_decode(const Args& a, unsigned char* ws, int r, TrD& d) {
    const float* W; bf16* WT; const float* gk = nullptr; int ldw, ldt, nblk, item;
    if (r < 2048) { const int l = r >> 9; item = r & 511; W = a.in[I_W_IN] + (size_t)l * DM * DM; ldw = DM; WT = (bf16*)(ws + WS_WIN + l * 3 * MiB); ldt = DM; nblk = 32; gk = a.in[I_NORM_MIX] + l * DM; }
    else if ((r -= 2048) < 2048) { const int l = r >> 9; item = r & 511;
        W = a.in[I_W_OUT] + (size_t)l * DM * DM; ldw = DM; WT = (bf16*)(ws + WS_WOUT + l * 2 * MiB); ldt = DM; nblk = 32;
        if (l < NA && item < 12 * 32) { WT = (bf16*)(ws + WS_TMPA + l * 2 * MiB); ldt = MAINW; } }
    else if ((r -= 2048) < 8192) { const int l = r >> 11; item = r & 2047; W = a.in[I_W_UP] + (size_t)l * DM * DFF; ldw = DFF; WT = (bf16*)(ws + WS_WUP + l * 8 * MiB); ldt = DM; nblk = 128; gk = a.in[I_NORM_MLP] + l * DM; }
    else if ((r -= 8192) < 8192) { const int l = r >> 11; item = r & 2047; W = a.in[I_W_DOWN] + (size_t)l * DFF * DM; ldw = DM; WT = (bf16*)(ws + WS_WDN + l * 8 * MiB); ldt = DFF; nblk = 32; }
    else if ((r -= 8192) < 1024) { const int l = r >> 8; item = r & 255; W = a.in[I_W_MEM_KV] + (size_t)l * DM * 512; ldw = 512; WT = (bf16*)(ws + WS_WMKV) + (size_t)l * 512 * DM; ldt = DM; nblk = 16; gk = a.in[I_MEM_NORM] + l * DM; }
    else { r -= 1024; item = r; W = a.in[I_W_KV]; ldw = 512; WT = (bf16*)(ws + WS_WIN + 2 * 3 * MiB) + (size_t)1024 * DM; ldt = DM; nblk = 16; gk = a.in[I_KV_NORM]; }
    const int kb = item / nblk, nb = item - kb * nblk, k0 = 64 * kb, n0 = 32 * nb;
    d.W = W + (size_t)k0 * ldw + n0; d.WT = WT + (size_t)n0 * ldt + k0; d.gk = gk ? gk + k0 : nullptr; d.ldw = ldw; d.ldt = ldt;
}
__device__ __forceinline__ void prologue(const Args& a, unsigned char* ws, LAS unsigned char* lds, int gw, int NGW, int lane, int wave) {
    LAS float* scr = (LAS float*)(lds + wave * 16384);
    {
        int it = gw; TrD dc; f32x4 vc[8];
        bool hc = it < NTR;
        if (hc) { tr_decode(a, ws, it, dc); tr_load(dc, vc, lane); }
        while (hc) {
            const int itn = it + NGW; const bool hn = itn < NTR;
            TrD dn = dc; f32x4 vn[8];
#pragma unroll
            for (int i = 0; i < 8; ++i) vn[i] = vc[i];
            if (hn) { tr_decode(a, ws, itn, dn); tr_load(dn, vn, lane); }
            tr_store(dc, vc, scr, lane);
            dc = dn;
#pragma unroll
            for (int i = 0; i < 8; ++i) vc[i] = vn[i];
            hc = hn; it = itn;
        }
    }
    for (int it = gw * 64 + lane; it < 2 * MAINW * (MAINW / 8); it += NGW * 64) {
        const int l = it / (MAINW * (MAINW / 8)), r = it - l * (MAINW * (MAINW / 8)), c = r / (MAINW / 8), ch = r - c * (MAINW / 8), g = c / 192;
        v4u o = (v4u){0u, 0u, 0u, 0u};
        if (ch / 24 == g) { const float* p = a.in[I_POOL_W] + ((size_t)(l * 4 + g) * 192 + (c - g * 192)) * 192 + (8 * ch - g * 192); const float* sc = a.in[I_POOL_SCALE] + l * MAINW + 8 * ch;
            const f32x4 p0 = *(const f32x4*)p, p1 = *(const f32x4*)(p + 4), s0 = *(const f32x4*)sc, s1 = *(const f32x4*)(sc + 4);
            o.x = pk2(p0[0] * s0[0], p0[1] * s0[1]); o.y = pk2(p0[2] * s0[2], p0[3] * s0[3]); o.z = pk2(p1[0] * s1[0], p1[1] * s1[1]); o.w = pk2(p1[2] * s1[2], p1[3] * s1[3]); }
        *(v4u*)((bf16*)(ws + WS_PP + l * 2 * MiB) + (size_t)c * MAINW + 8 * ch) = o;
    }
    for (int m = gw; m < MROWS; m += NGW) rms_row(a.in[I_MEM] + (size_t)m * DM, (bf16*)(ws + WS_MEMN) + (size_t)m * DM, lane);
    {
        int m = gw; XRows xc;
        if (m < M) xrows_load(xc, a.in[I_X] + (size_t)m * DM, a.in[I_X] + (size_t)(m + NGW) * DM, lane);
        while (m < M) {
            const int mn = m + 2 * NGW; XRows xn = xc;
            if (mn < M) xrows_load(xn, a.in[I_X] + (size_t)mn * DM, a.in[I_X] + (size_t)(mn + NGW) * DM, lane);
            xrows_store(xc, (bf16*)(ws + WS_XN) + (size_t)m * DM, (bf16*)(ws + WS_XN) + (size_t)(m + NGW) * DM,
                        (float*)(ws + WS_SSQ + 2 * MiB) + (size_t)m * 16, (float*)(ws + WS_SSQ + 2 * MiB) + (size_t)(m + NGW) * 16, lane);
            xc = xn; m = mn;
        }
    }
}

enum { K_PRO = 0, K_INPROJ, K_MIX, K_OUT, K_UP, K_DOWN };
constexpr int NPHASES = 21;
__device__ __forceinline__ void decode_phase(int ph, int& kind, int& l) {
    if (ph == 0) { kind = K_PRO; l = 0; return; }
    const int p = ph - 1; l = p / 5; const int k = p - 5 * l;
    kind = (k == 0) ? K_INPROJ : (k == 1) ? K_MIX : (k == 2) ? K_OUT : (k == 3) ? K_UP : K_DOWN;
}

__global__ void __launch_bounds__(NTHR, 2) fwd_kernel(Args a) {
    extern __shared__ __attribute__((aligned(16))) unsigned char lds_raw[];
    LAS unsigned char* lds = (LAS unsigned char*)lds_raw;
    volatile LAS unsigned* MISC = (volatile LAS unsigned*)(lds + MISC_OFF);
    if (threadIdx.x < 64) MISC[threadIdx.x] = 0u;
    __syncthreads();
    const int lo = a.ph_lo, hi = a.ph_hi;
    XcdBarrier bar; bar.bar = (unsigned*)(a.ws + WS_CTL); bar.x = 0; bar.st = nullptr;
    if (hi - lo > 1) bar = xcd_barrier_post((unsigned*)(a.ws + WS_CTL), MISC + 8);
    if (lo < 0) { cg::this_grid().sync(); }

    for (int ph = lo; ph < hi; ++ph) {
        int tid = threadIdx.x, bx = blockIdx.x, G = gridDim.x; unsigned long long zo = 0;
        asm volatile("" : "+v"(tid)); asm volatile("" : "+s"(bx), "+s"(G)); asm volatile("" : "+s"(zo));
        unsigned char* ws = a.ws + zo; float* outp = (float*)((unsigned char*)a.out + zo);
        const int lane = tid & 63, wave = __builtin_amdgcn_readfirstlane(tid >> 6);
        const int gw = bx * NWAVES + wave, NGW = G * NWAVES, gthread = bx * NTHR + tid, nthreads = G * NTHR;
        bf16* const XN = (bf16*)(ws + WS_XN);
        bf16* const PROJ = (bf16*)(ws + WS_BIG);
        bf16* const CAT = (bf16*)(ws + WS_BIG + 64 * MiB);
        bf16* const HID = (bf16*)(ws + WS_BIG);
        bf16* const KV = (bf16*)(ws + WS_KV);
        bf16* const MKV = (bf16*)(ws + WS_MKV);
        int kind, l; decode_phase(ph, kind, l);
        float* const SSQ0 = (float*)(ws + WS_SSQ);
        float* const SSQ1 = (float*)(ws + WS_SSQ + 2 * MiB);
        if (kind == K_PRO) {
            prologue(a, ws, lds, gw, NGW, lane, wave);
        } else if (kind == K_MIX) {
            MixP P; P.PROJ = PROJ; P.KV = KV; P.MKV = MKV; P.CAT = CAT; P.knorm = a.in[I_K_NORM]; P.qnorm = a.in[I_Q_NORM]; P.sinks = a.in[I_SINKS];
            P.mknorm = a.in[I_MEM_K_NORM]; P.mqnorm = a.in[I_MEM_Q_NORM]; P.l = l;
            att::StageRegs R;
            int v = (l < NA) ? 512 + bx : bx;
            if (l < NA) pool_pass(PROJ, CAT, bx, G, wave, lane);
            unit_load(P, v, tid, wave, R);
            while (v < 768) {
                unit_write(P, v, lds, tid, R);
                LDS_WAIT(); __syncthreads();
                const int vn = v + G;
                if (v < 512) { if (vn < 768) unit_load(P, vn, tid, wave, R); unit_tasks(P, v, lds, tid, wave); }
                else { unit_tasks(P, v, lds, tid, wave); if (vn < 768) unit_load(P, vn, tid, wave, R); }
                __syncthreads();
                v = vn;
            }
        } else {
            const int ng = (kind == K_INPROJ && l == 0) ? 4 : 1;
            for (int gi = 0; gi < ng; ++gi) {
                pg8::Gemm g; pg8::EpiB E; E.O2 = KV; E.ldc2 = 512; E.split_pn = 1 << 30; E.mode = 0; E.ssq_in = nullptr; E.ssq_out = SSQ0; E.outf = outp; E.scr = lds + EPI_SCR_OFF; g.M = M; g.K = DM;
                int cb = bx;
                if (kind == K_INPROJ && ng == 4 && gi == 0) { g.A = (const bf16*)(ws + WS_MEMN); g.Bt = (const bf16*)(ws + WS_WMKV); g.M = MROWS; g.N = 2048; E.O1 = MKV; E.ldc1 = 2048; }
                else if (kind == K_INPROJ && ng == 4 && gi < 3) {
                    const int fl = gi - 1; g.A = (const bf16*)(ws + WS_TMPA + fl * 2 * MiB); g.Bt = (const bf16*)(ws + WS_PP + fl * 2 * MiB); g.M = DM; g.N = MAINW; g.K = MAINW;
                    E.O1 = (bf16*)(ws + WS_WOUT + fl * 2 * MiB); E.ldc1 = DM; cb = (bx + G - 64 - 12 * fl) % G; }
                else if (kind == K_INPROJ) { g.A = XN; g.Bt = (const bf16*)(ws + WS_WIN + l * 3 * MiB); g.N = (l == 2) ? 1536 : 1024; E.O1 = PROJ; E.ldc1 = 1024; E.split_pn = 4; E.ssq_in = SSQ1; }
                else if (kind == K_OUT) { g.A = CAT; g.Bt = (const bf16*)(ws + WS_WOUT + l * 2 * MiB); g.N = DM; E.O1 = XN; E.ldc1 = DM; E.mode = 2; }
                else if (kind == K_UP) { g.A = XN; g.Bt = (const bf16*)(ws + WS_WUP + l * 8 * MiB); g.N = DFF; E.O1 = HID; E.ldc1 = DFF; E.mode = 1; }
                else { g.A = HID; g.Bt = (const bf16*)(ws + WS_WDN + l * 8 * MiB); g.N = DM; g.K = DFF; E.O1 = XN; E.ldc1 = DM; E.mode = (l == DEPTH - 1) ? 3 : 2; E.ssq_in = SSQ0; E.ssq_out = SSQ1; }
                pg8::StaticOrder S; S.init(g.M, g.N, G, cb);
                pg8::gemm_phase<pg8::EpiB, pg8::StaticOrder, true, true>(lds, g, S, E);
            }
        }
        if (ph + 1 < hi) { bar.bar = (unsigned*)(ws + WS_CTL); xcd_barrier(bar); }
    }
}

#ifndef PER_PHASE_LAUNCH
#define PER_PHASE_LAUNCH 0
#endif
extern "C" void kernel_launch(void* const* d_in, const int* in_sizes, int n_in, void* d_out, int out_size, void* d_ws, size_t ws_size, hipStream_t stream) {
    static int grid = 0;
    if (grid == 0) {
        if (n_in != 19 || out_size != M * DM || ws_size < WS_END) { fprintf(stderr, "kernel_launch: unexpected shapes (n_in %d out %d ws %zu)\n", n_in, out_size, ws_size); grid = -1; return; }
        int dev = 0, cus = 0, per_cu = 0;
        if (hipGetDevice(&dev) != hipSuccess || hipDeviceGetAttribute(&cus, hipDeviceAttributeMultiprocessorCount, dev) != hipSuccess) { grid = -1; return; }
        if (hipFuncSetAttribute((const void*)fwd_kernel, hipFuncAttributeMaxDynamicSharedMemorySize, LDS_BYTES) != hipSuccess) { fprintf(stderr, "kernel_launch: hipFuncSetAttribute failed\n"); grid = -1; return; }
        if (hipOccupancyMaxActiveBlocksPerMultiprocessor(&per_cu, (const void*)fwd_kernel, NTHR, LDS_BYTES) != hipSuccess || per_cu < 1) { fprintf(stderr, "kernel_launch: occupancy query says %d\n", per_cu); per_cu = 1; }
        (void)hipGetLastError();
        grid = cus < 256 ? cus : 256;
    }
    if (grid < 0) return;
    (void)hipMemsetAsync((char*)d_ws + WS_CTL, 0, CTL_BYTES, stream);
    Args a{};
    for (int i = 0; i < 19; ++i) a.in[i] = (const float*)d_in[i];
    a.out = (float*)d_out; a.ws = (unsigned char*)d_ws;
#if PER_PHASE_LAUNCH
    for (int ph = 0; ph < NPHASES; ++ph) {
        a.ph_lo = ph; a.ph_hi = ph + 1;
        hipLaunchKernelGGL(fwd_kernel, dim3(grid), dim3(NTHR), LDS_BYTES, stream, a);
    }
#else
    a.ph_lo = 0; a.ph_hi = NPHASES;
    void* params[] = {&a};
    hipError_t e = hipLaunchCooperativeKernel((const void*)fwd_kernel, dim3(grid), dim3(NTHR), params, LDS_BYTES, stream);
    if (e != hipSuccess) fprintf(stderr, "cooperative launch failed: %s (grid %d)\n", hipGetErrorString(e), grid);
#endif
}
```

```cpp
#include <hip/hip_runtime.h>
#include <hip/hip_cooperative_groups.h>
#include <cstdio>
#include <cstdint>
namespace cg = cooperative_groups;
namespace pg8 {
#define PG8_LAS __attribute__((address_space(3)))
typedef unsigned short bf16_t;
typedef short bf16x8 __attribute__((ext_vector_type(8)));
typedef float f32x4 __attribute__((ext_vector_type(4)));
typedef unsigned u32x4 __attribute__((ext_vector_type(4)));
constexpr int BM = 256, BK = 64, HALF = 128, HTB = HALF * BK * 2  , STAGE_BYTES = 8 * HTB, NXCD = 8, WGM = 8;

__host__ __device__ __forceinline__ int lds_byte(int r, int c) { const int st = (r >> 4) * 2 + (c >> 5), rr = r & 15, cc = c & 31, ob = rr * 64 + cc * 2; return st * 1024 + (ob ^ (((ob >> 9) & 1) << 5)); }
__host__ __device__ __forceinline__ void stage_rc(int b, int& R, int& C) { const int st = b / 1024, sb = b % 1024, swz = sb ^ (((sb >> 9) & 1) << 5); R = (st >> 1) * 16 + swz / 64; C = (st & 1) * 32 + (swz % 64) / 2; }
__host__ __device__ __forceinline__ int perm32(int rho) { const int n = rho >> 4, i = rho & 15; return 8 * (i >> 2) + 4 * n + (i & 3); }

struct Unit { int pm, pn; };
struct Gemm { const bf16_t* A; const bf16_t* Bt; int M, N, K; };

struct StaticOrder {
    int nM, nN, nwg, G, c;
    __host__ __device__ void init(int M, int N, int G_, int c_) { nM = M / BM; nN = N / BM; nwg = nM * nN; G = G_; c = c_; }
    __host__ __device__ bool next(int i, Unit& u) const {
        const long L = (long)i * G + c; if (L >= nwg) return false;
        int wgid = (int)L; { const int q = nwg / NXCD, r = nwg % NXCD, xcd = wgid % NXCD, off = wgid / NXCD; wgid = (xcd < r ? xcd * (q + 1) : r * (q + 1) + (xcd - r) * q) + off; }
        const int nig = WGM * nN, gid = wgid / nig, fm = gid * WGM, gsz = (nM - fm) < WGM ? (nM - fm) : WGM;
        u.pm = fm + ((wgid % nig) % gsz); u.pn = (wgid % nig) / gsz; return true;
    }
    __device__ __forceinline__ void a_ready(const Unit&) const {}
    __device__ __forceinline__ void done(const Unit&) const {}
};

typedef float f32x2 __attribute__((ext_vector_type(2)));
typedef __bf16 bf16x2_t __attribute__((ext_vector_type(2)));
__device__ __forceinline__ unsigned cvt_pk_bf16(float lo, float hi) { f32x2 v = {lo, hi}; bf16x2_t b = __builtin_convertvector(v, bf16x2_t); return __builtin_bit_cast(unsigned, b); }
__device__ __forceinline__ float bflo(unsigned u) { return __builtin_bit_cast(float, u << 16); }
__device__ __forceinline__ float bfhi(unsigned u) { return __builtin_bit_cast(float, u & 0xffff0000u); }

#ifndef EPI_ST
#define EPI_ST 0
#endif
__device__ __forceinline__ void st16(void* p, u32x4 v) {
#if EPI_ST == 1
    asm volatile("global_store_dwordx4 %0, %1, off sc1\n\ts_nop 1" :: "v"(p), "v"(v) : "memory");
#elif EPI_ST == 2
    __builtin_nontemporal_store(v, (u32x4*)p);
#else
    *(u32x4*)p = v;
#endif
}
__device__ __forceinline__ float relu_f(float x) { float y; asm("v_max_f32_e32 %0, 0, %1" : "=v"(y) : "v"(x)); return y; }
struct EpiB {
    static constexpr bool PERM = true, AFTER_DRAIN = false, WIDE = true;
    static constexpr int SCR_PITCH = 144, SCR_BYTES = 16 * SCR_PITCH;
    bf16_t* O1; int ldc1; bf16_t* O2; int ldc2; int split_pn; int mode; const float* ssq_in; float* ssq_out; float* outf; PG8_LAS unsigned char* scr;
    template <int MODE>
    __device__ __forceinline__ void body(const f32x4 (&acc)[2][2][4][2], bf16_t* base, int ldc, int rowt, int colw, const float (&rs)[2][4], int pn, int wr, int wc, int fr, int fq) const {
        const int col0 = colw + 8 * fq;
        if (MODE == 3) {
            PG8_LAS unsigned char* wscr3 = scr + (wr * 4 + wc) * SCR_BYTES;
            const int lane3 = fr + 16 * fq, rr3 = lane3 >> 3, ch3 = lane3 & 7;
#pragma unroll
            for (int ai = 0; ai < 2; ++ai) {
                u32x4 hl3[4][2];
#pragma unroll
                for (int m = 0; m < 4; ++m)
#pragma unroll
                    for (int k = 0; k < 2; ++k) hl3[m][k] = *(const u32x4*)(base + (size_t)(rowt + ai * HALF + wr * 64 + m * 16 + 8 * k + rr3) * ldc + colw + 8 * ch3);
#pragma unroll
                for (int m = 0; m < 4; ++m) {
                    const int rowg = rowt + ai * HALF + wr * 64 + m * 16;
                    const u32x4 hl0 = hl3[m][0], hl1 = hl3[m][1];
                    *(PG8_LAS u32x4*)(wscr3 + rr3 * SCR_PITCH + ch3 * 16) = hl0; *(PG8_LAS u32x4*)(wscr3 + (rr3 + 8) * SCR_PITCH + ch3 * 16) = hl1;
                    u32x4 hb[2]; hb[0] = *(const PG8_LAS u32x4*)(wscr3 + fr * SCR_PITCH + fq * 16); hb[1] = *(const PG8_LAS u32x4*)(wscr3 + fr * SCR_PITCH + fq * 16 + 64);
#pragma unroll
                    for (int bj = 0; bj < 2; ++bj) {
                        const u32x4 h = hb[bj];
                        f32x4 v0 = acc[ai][bj][m][0] * rs[ai][m], v1 = acc[ai][bj][m][1] * rs[ai][m];
                        v0[0] += bflo(h.x); v0[1] += bfhi(h.x); v0[2] += bflo(h.y); v0[3] += bfhi(h.y);
                        v1[0] += bflo(h.z); v1[1] += bfhi(h.z); v1[2] += bflo(h.w); v1[3] += bfhi(h.w);
                        *(PG8_LAS f32x4*)(wscr3 + fr * SCR_PITCH + fq * 32) = v0; *(PG8_LAS f32x4*)(wscr3 + fr * SCR_PITCH + fq * 32 + 16) = v1;
                        const f32x4 o0 = *(const PG8_LAS f32x4*)(wscr3 + rr3 * SCR_PITCH + ch3 * 16), o1 = *(const PG8_LAS f32x4*)(wscr3 + (rr3 + 8) * SCR_PITCH + ch3 * 16);
                        float* op = outf + (size_t)(rowg + rr3) * ldc + colw + 32 * bj + 4 * ch3;
                        *(f32x4*)op = o0; *(f32x4*)(op + (size_t)8 * ldc) = o1;
                    }
                }
            }
            return;
        }
        PG8_LAS unsigned char* wscr = scr + (wr * 4 + wc) * SCR_BYTES;
        PG8_LAS unsigned char* wp = wscr + fr * SCR_PITCH + fq * 16;
        const int lane = fr + 16 * fq, rr = lane >> 3, ch = lane & 7;
        const PG8_LAS unsigned char* rp = wscr + rr * SCR_PITCH + ch * 16;
#pragma unroll
        for (int ai = 0; ai < 2; ++ai) {
            u32x4 hl[4][2];
            if (MODE == 2) {
#pragma unroll
                for (int m = 0; m < 4; ++m)
#pragma unroll
                    for (int k = 0; k < 2; ++k) hl[m][k] = *(const u32x4*)(base + (size_t)(rowt + ai * HALF + wr * 64 + m * 16 + 8 * k + rr) * ldc + colw + 8 * ch);
            }
#pragma unroll
            for (int m = 0; m < 4; ++m) {
                const int rowg = rowt + ai * HALF + wr * 64 + m * 16;
                float ss = 0.f;
                u32x4 hb[2];
                if (MODE == 2) {
                    *(PG8_LAS u32x4*)(wscr + rr * SCR_PITCH + ch * 16) = hl[m][0]; *(PG8_LAS u32x4*)(wscr + (rr + 8) * SCR_PITCH + ch * 16) = hl[m][1];
                    hb[0] = *(const PG8_LAS u32x4*)wp; hb[1] = *(const PG8_LAS u32x4*)(wp + 64);
                }
#pragma unroll
                for (int bj = 0; bj < 2; ++bj) {
                    f32x4 v0 = acc[ai][bj][m][0], v1 = acc[ai][bj][m][1];
                    if (MODE == 0) { v0 = v0 * rs[ai][m]; v1 = v1 * rs[ai][m]; }
                    else if (MODE == 1) {
#pragma unroll
                        for (int e = 0; e < 4; ++e) { const float x = relu_f(v0[e]); v0[e] = x * x; const float y = relu_f(v1[e]); v1[e] = y * y; } }
                    else { const u32x4 h = hb[bj]; v0 = v0 * rs[ai][m]; v1 = v1 * rs[ai][m];
                        v0[0] += bflo(h.x); v0[1] += bfhi(h.x); v0[2] += bflo(h.y); v0[3] += bfhi(h.y);
                        v1[0] += bflo(h.z); v1[1] += bfhi(h.z); v1[2] += bflo(h.w); v1[3] += bfhi(h.w); }
                    u32x4 w; w.x = cvt_pk_bf16(v0[0], v0[1]); w.y = cvt_pk_bf16(v0[2], v0[3]); w.z = cvt_pk_bf16(v1[0], v1[1]); w.w = cvt_pk_bf16(v1[2], v1[3]);
                    if (MODE == 2) { const float r0 = bflo(w.x), r1 = bfhi(w.x), r2 = bflo(w.y), r3 = bfhi(w.y), r4 = bflo(w.z), r5 = bfhi(w.z), r6 = bflo(w.w), r7 = bfhi(w.w);
                        ss += ((r0 * r0 + r1 * r1) + (r2 * r2 + r3 * r3)) + ((r4 * r4 + r5 * r5) + (r6 * r6 + r7 * r7)); }
                    *(PG8_LAS u32x4*)(wp + 64 * bj) = w;
                }
                const u32x4 l0 = *(const PG8_LAS u32x4*)rp, l1 = *(const PG8_LAS u32x4*)(rp + 8 * SCR_PITCH);
                bf16_t* gp = base + (size_t)(rowg + rr) * ldc + colw + 8 * ch;
                st16(gp, l0); st16(gp + (size_t)8 * ldc, l1);
                if (MODE == 2) {
                    ss += __shfl_xor(ss, 16); ss += __shfl_xor(ss, 32);
                    if (fq == 0) ssq_out[(size_t)(rowg + fr) * 16 + pn * 4 + wc] = ss;
                }
            }
        }
    }
    __device__ __forceinline__ void operator()(const f32x4 (&acc)[2][2][4][2], const Unit& u, int wr, int wc, int fr, int fq) const {
        const int row0 = u.pm * BM + wr * 64 + fr;
        bf16_t* base = O1; int ldc = ldc1; int colt = u.pn * BM;
        if (u.pn >= split_pn) { base = O2; ldc = ldc2; colt = (u.pn - split_pn) * BM; }
        const int colw = colt + wc * 64;
        float rs[2][4];
        if (ssq_in) {
            const int lane = fr + 16 * fq, rq = lane >> 2, cq = lane & 3;
            f32x4 q[2][4];
#pragma unroll
            for (int ai = 0; ai < 2; ++ai)
#pragma unroll
                for (int m = 0; m < 4; ++m) q[ai][m] = *(const f32x4*)(ssq_in + (size_t)(u.pm * BM + ai * HALF + wr * 64 + m * 16 + rq) * 16 + 4 * cq);
#pragma unroll
            for (int ai = 0; ai < 2; ++ai)
#pragma unroll
                for (int m = 0; m < 4; ++m) { float t = (q[ai][m][0] + q[ai][m][1]) + (q[ai][m][2] + q[ai][m][3]); t += __shfl_xor(t, 1); t += __shfl_xor(t, 2);
                    const float tr = __shfl(t, 4 * fr);
                    const float r = __builtin_amdgcn_rsqf(tr * (1.0f / 1024.0f) + 1e-6f); rs[ai][m] = (mode >= 2) ? r * r : r; }
        } else {
#pragma unroll
            for (int ai = 0; ai < 2; ++ai)
#pragma unroll
                for (int m = 0; m < 4; ++m) rs[ai][m] = 1.0f;
        }
        const int rowt = u.pm * BM;
        if (mode == 1) body<1>(acc, base, ldc, rowt, colw, rs, u.pn, wr, wc, fr, fq);
        else if (mode == 0) body<0>(acc, base, ldc, rowt, colw, rs, u.pn, wr, wc, fr, fq);
        else if (mode == 2) body<2>(acc, base, ldc, rowt, colw, rs, u.pn, wr, wc, fr, fq);
        else body<3>(acc, base, ldc, rowt, colw, rs, u.pn, wr, wc, fr, fq);
    }
};

template <class Epi, class Sched, bool ALIGN_EPI = false, bool SP2 = false>
__device__ __forceinline__ void gemm_phase(PG8_LAS unsigned char* lds, const Gemm g, const Sched& S, const Epi& E) {
    int tid_ = threadIdx.x; asm volatile("" : "+v"(tid_));
    const int tid = tid_, wid = __builtin_amdgcn_readfirstlane(tid >> 6), lane = tid & 63, wr = wid >> 2, wc = wid & 3, fr = lane & 15, fq = lane >> 4;
    const int K = g.K, nt = K / BK;
    unsigned voffA[2], voffB[2];
#pragma unroll
    for (int i = 0; i < 2; ++i) { int R, C; stage_rc(tid * 16 + i * 8192, R, C); const int Rb = Epi::PERM ? (Epi::WIDE ? (64 * (R >> 5) + perm32(R & 31)) : ((R & ~31) + perm32(R & 31))) : R;
        voffA[i] = (unsigned)(R * K + C) * 2u; voffB[i] = (unsigned)(Rb * K + C) * 2u; }
    const size_t kstep = (size_t)(BK * 2);
    const size_t hstep = (size_t)HALF * K * 2;
    const size_t tstep = 2 * hstep;
    const size_t hstepB = (Epi::PERM && Epi::WIDE) ? (size_t)32 * K * 2 : hstep;
    const unsigned ldsw = (unsigned)wid * 1024u;
    const int aoff = lds_byte(wr * 64 + fr, fq * 8), boff = lds_byte(wc * 32 + fr, fq * 8);
#define PG8_SA(b, h) (((b) * 2 + (h)) * HTB)
#define PG8_SB(b, h) ((4 + (b) * 2 + (h)) * HTB)
#define PG8_STAGE(bufoff, gbase, voff) do { _Pragma("unroll") for (int _i = 0; _i < 2; ++_i) \
        __builtin_amdgcn_global_load_lds((const unsigned*)((const char*)(gbase) + (voff)[_i]), (PG8_LAS unsigned*)(lds + (bufoff) + ldsw + _i * 8192), 16, 0, 0); } while (0)
#define PG8_LDA(dst, b, h) do { _Pragma("unroll") for (int m = 0; m < 4; ++m) _Pragma("unroll") for (int k = 0; k < 2; ++k) dst[m][k] = *(const PG8_LAS bf16x8*)(lds + PG8_SA(b, h) + aoff + m * 2048 + k * 1024); } while (0)
#define PG8_LDB(dst, b, h) do { _Pragma("unroll") for (int n = 0; n < 2; ++n) _Pragma("unroll") for (int k = 0; k < 2; ++k) dst[n][k] = *(const PG8_LAS bf16x8*)(lds + PG8_SB(b, h) + boff + n * 2048 + k * 1024); } while (0)
#define PG8_MMA(ai, bj, At, Bt) do { __builtin_amdgcn_s_setprio(1); _Pragma("unroll") for (int m = 0; m < 4; ++m) _Pragma("unroll") for (int n = 0; n < 2; ++n) _Pragma("unroll") for (int k = 0; k < 2; ++k) \
        acc[ai][bj][m][n] = __builtin_amdgcn_mfma_f32_16x16x32_bf16(Bt[n][k], At[m][k], acc[ai][bj][m][n], 0, 0, 0); __builtin_amdgcn_s_setprio(0); } while (0)
#define PG8_WAIT_V(n) asm volatile("s_waitcnt vmcnt(" #n ")" ::: "memory")
#define PG8_WAIT_L(n) asm volatile("s_waitcnt lgkmcnt(" #n ")" ::: "memory")
#define PG8_BAR __builtin_amdgcn_s_barrier()
#define PG8_SCHED __builtin_amdgcn_sched_barrier(0)
    Unit cur, nxt; int ui = 0;
    if (!S.next(0, cur)) return;
    f32x4 acc[2][2][4][2];
#pragma unroll
    for (int a = 0; a < 2; ++a)
#pragma unroll
        for (int b = 0; b < 2; ++b)
#pragma unroll
            for (int m = 0; m < 4; ++m)
#pragma unroll
                for (int n = 0; n < 2; ++n) acc[a][b][m][n] = (f32x4){0.f, 0.f, 0.f, 0.f};
    bf16x8 At[4][2], B0[2][2], B1[2][2];
    const char* cA = (const char*)g.A + (size_t)cur.pm * tstep; const char* cB = (const char*)g.Bt + (size_t)cur.pn * tstep;
    S.a_ready(cur);
    if constexpr (SP2) {
        PG8_STAGE(PG8_SB(0, 0), cB, voffB); PG8_STAGE(PG8_SB(0, 1), cB + hstepB, voffB); PG8_STAGE(PG8_SA(0, 0), cA, voffA); PG8_STAGE(PG8_SA(0, 1), cA + hstep, voffA);
        if (wr == 1) PG8_BAR;
        PG8_WAIT_V(2); PG8_BAR;
        PG8_STAGE(PG8_SB(1, 0), cB + kstep, voffB); PG8_STAGE(PG8_SA(1, 0), cA + kstep, voffA); PG8_STAGE(PG8_SB(1, 1), cB + hstepB + kstep, voffB);
        PG8_WAIT_V(6); PG8_BAR;
    } else {
        PG8_STAGE(PG8_SB(0, 0), cB, voffB); PG8_STAGE(PG8_SA(0, 0), cA, voffA); PG8_STAGE(PG8_SB(0, 1), cB + hstepB, voffB); PG8_STAGE(PG8_SA(0, 1), cA + hstep, voffA);
        if (wr == 1) PG8_BAR;
        PG8_WAIT_V(4); PG8_BAR;
        PG8_STAGE(PG8_SB(1, 0), cB + kstep, voffB); PG8_STAGE(PG8_SA(1, 0), cA + kstep, voffA); PG8_STAGE(PG8_SB(1, 1), cB + hstepB + kstep, voffB);
        PG8_WAIT_V(6); PG8_BAR;
    }
    for (;;) {
        const bool has_next = S.next(ui + 1, nxt);
        const char* nA = has_next ? (const char*)g.A + (size_t)nxt.pm * tstep : cA; const char* nB = has_next ? (const char*)g.Bt + (size_t)nxt.pn * tstep : cB;
        for (int t = 0; t < nt; t += 2) {
            const bool last = (t == nt - 2);
            const char* a1 = cA + (size_t)(t + 1) * kstep;
            const char* a2 = last ? nA : cA + (size_t)(t + 2) * kstep; const char* b2 = last ? nB : cB + (size_t)(t + 2) * kstep;
            const char* a3 = a2 + kstep; const char* b3 = b2 + kstep;
            if (last && has_next) S.a_ready(nxt);
            if constexpr (SP2) {
            PG8_LDB(B0, 0, 0); PG8_LDB(B1, 0, 1); PG8_SCHED; PG8_LDA(At, 0, 0); PG8_STAGE(PG8_SA(1, 1), a1 + hstep, voffA);
            PG8_WAIT_V(8); PG8_WAIT_L(0); PG8_BAR; PG8_MMA(0, 0, At, B0); PG8_MMA(0, 1, At, B1); PG8_BAR; PG8_SCHED;
            PG8_LDA(At, 0, 1); PG8_STAGE(PG8_SB(0, 0), b2, voffB); PG8_STAGE(PG8_SB(0, 1), b2 + hstepB, voffB); PG8_STAGE(PG8_SA(0, 0), a2, voffA);
            PG8_WAIT_V(8); PG8_WAIT_L(0); PG8_BAR; PG8_MMA(1, 0, At, B0); PG8_MMA(1, 1, At, B1); PG8_BAR; PG8_SCHED;
            PG8_LDB(B0, 1, 0); PG8_LDB(B1, 1, 1); PG8_SCHED; PG8_LDA(At, 1, 0); PG8_STAGE(PG8_SA(0, 1), a2 + hstep, voffA);
            PG8_WAIT_V(8); PG8_WAIT_L(0); PG8_BAR; PG8_MMA(0, 0, At, B0); PG8_MMA(0, 1, At, B1); PG8_BAR; PG8_SCHED;
            PG8_LDA(At, 1, 1); PG8_STAGE(PG8_SB(1, 0), b3, voffB); PG8_STAGE(PG8_SB(1, 1), b3 + hstepB, voffB); PG8_STAGE(PG8_SA(1, 0), a3, voffA);
            PG8_WAIT_V(8); PG8_WAIT_L(0); PG8_BAR; PG8_MMA(1, 0, At, B0); PG8_MMA(1, 1, At, B1); PG8_BAR; PG8_SCHED;
            } else {
            PG8_LDB(B0, 0, 0); PG8_SCHED; PG8_LDA(At, 0, 0); PG8_STAGE(PG8_SA(1, 1), a1 + hstep, voffA);
            PG8_WAIT_L(8); PG8_BAR; PG8_WAIT_L(0); PG8_MMA(0, 0, At, B0); PG8_BAR; PG8_SCHED;
            PG8_LDB(B1, 0, 1); PG8_STAGE(PG8_SB(0, 0), b2, voffB);
            PG8_BAR; PG8_WAIT_L(0); PG8_MMA(0, 1, At, B1); PG8_BAR;
            PG8_LDA(At, 0, 1); PG8_STAGE(PG8_SA(0, 0), a2, voffA);
            PG8_BAR; PG8_WAIT_L(0); PG8_MMA(1, 0, At, B0); PG8_BAR; PG8_SCHED;
            PG8_STAGE(PG8_SB(0, 1), b2 + hstepB, voffB);
            PG8_WAIT_V(6); PG8_BAR; PG8_MMA(1, 1, At, B1); PG8_BAR;
            PG8_LDB(B0, 1, 0); PG8_SCHED; PG8_LDA(At, 1, 0); PG8_STAGE(PG8_SA(0, 1), a2 + hstep, voffA);
            PG8_WAIT_L(8); PG8_BAR; PG8_WAIT_L(0); PG8_MMA(0, 0, At, B0); PG8_BAR; PG8_SCHED;
            PG8_LDB(B1, 1, 1); PG8_STAGE(PG8_SB(1, 0), b3, voffB);
            PG8_BAR; PG8_WAIT_L(0); PG8_MMA(0, 1, At, B1); PG8_BAR;
            PG8_LDA(At, 1, 1); PG8_STAGE(PG8_SA(1, 0), a3, voffA);
            PG8_BAR; PG8_WAIT_L(0); PG8_MMA(1, 0, At, B0); PG8_BAR; PG8_SCHED;
            PG8_STAGE(PG8_SB(1, 1), b3 + hstepB, voffB);
            PG8_WAIT_V(6); PG8_BAR; PG8_MMA(1, 1, At, B1); PG8_BAR;
            }
        }
        if constexpr (ALIGN_EPI) { if (wr == 0) PG8_BAR; }
        if constexpr (!Epi::AFTER_DRAIN) { E(acc, cur, wr, wc, fr, fq); S.done(cur); }
        if (!has_next) break;
#pragma unroll
        for (int a = 0; a < 2; ++a)
#pragma unroll
            for (int b = 0; b < 2; ++b)
#pragma unroll
                for (int m = 0; m < 4; ++m)
#pragma unroll
                    for (int n = 0; n < 2; ++n) acc[a][b][m][n] = (f32x4){0.f, 0.f, 0.f, 0.f};
        cur = nxt; cA = nA; cB = nB; ++ui;
        if constexpr (ALIGN_EPI) { if (wr == 1) PG8_BAR; }
    }
    PG8_WAIT_V(0);
    if constexpr (!ALIGN_EPI) { if (wr == 0) PG8_BAR; }
    PG8_BAR;
    if constexpr (Epi::AFTER_DRAIN) { E.fused(acc, cur, wr, wc, fr, fq, lds, wid, lane); S.done(cur); }
#undef PG8_SA
#undef PG8_SB
#undef PG8_STAGE
#undef PG8_LDA
#undef PG8_LDB
#undef PG8_MMA
#undef PG8_WAIT_V
#undef PG8_WAIT_L
#undef PG8_BAR
#undef PG8_SCHED
}
}

constexpr int NWAVES = 8, NTHR = 512;
constexpr int DM = 1024, BATCH = 8, SEQ = 4096, DEPTH = 4, NA = 2;
constexpr int M = BATCH * SEQ;
constexpr int HD = 64, MEMLEN = 256, MAINW = 768, DFF = 4096;
constexpr int MROWS = BATCH * MEMLEN;
constexpr float EPS = 1e-6f;
constexpr float LOG2E = 1.4426950408889634f;

constexpr size_t MiB = 1u << 20;
constexpr size_t WS_WIN = 0;
constexpr size_t WS_WOUT = 12 * MiB;
constexpr size_t WS_WUP = 20 * MiB;
constexpr size_t WS_WDN = 52 * MiB;
constexpr size_t WS_WMKV = 84 * MiB;
constexpr size_t WS_WPOOL = 88 * MiB;
constexpr size_t WS_MEMN = 92 * MiB;
constexpr size_t WS_MKV = 96 * MiB;
constexpr size_t WS_KV = 104 * MiB;
constexpr size_t WS_XN = 136 * MiB;
constexpr size_t WS_BIG = 200 * MiB;
constexpr size_t WS_CTL = 456 * MiB;
constexpr size_t CTL_BYTES = 65536;
constexpr size_t WS_SSQ = 457 * MiB;
constexpr size_t WS_END = 461 * MiB;

constexpr int LDS_BYTES = 155648;
constexpr int EPI_SCR_OFF = 135168;
constexpr int MISC_OFF = 131072;

#define LAS __attribute__((address_space(3)))
typedef unsigned short bf16;
typedef unsigned v4u __attribute__((ext_vector_type(4)));
typedef unsigned v2u __attribute__((ext_vector_type(2)));
typedef float f32x4 __attribute__((ext_vector_type(4)));
typedef float f32x16 __attribute__((ext_vector_type(16)));
typedef short bf16x8 __attribute__((ext_vector_type(8)));
typedef short s16x4 __attribute__((ext_vector_type(4)));
#define LDS_WAIT() asm volatile("s_waitcnt lgkmcnt(0)" ::: "memory")
__device__ __forceinline__ unsigned pk2(float lo, float hi) { return pg8::cvt_pk_bf16(lo, hi); }
__device__ __forceinline__ float bf_lo(unsigned u) { return __uint_as_float(u << 16); }
__device__ __forceinline__ float bf_hi(unsigned u) { return __uint_as_float(u & 0xffff0000u); }
__device__ __forceinline__ void unpack8(const v4u r, float* f) { f[0] = bf_lo(r.x); f[1] = bf_hi(r.x); f[2] = bf_lo(r.y); f[3] = bf_hi(r.y); f[4] = bf_lo(r.z); f[5] = bf_hi(r.z); f[6] = bf_lo(r.w); f[7] = bf_hi(r.w); }
__device__ __forceinline__ v4u pack8(const float* f) { v4u o; o.x = pk2(f[0], f[1]); o.y = pk2(f[2], f[3]); o.z = pk2(f[4], f[5]); o.w = pk2(f[6], f[7]); return o; }
__device__ __forceinline__ float wave_sum(float v) {
#pragma unroll
    for (int o = 1; o < 64; o <<= 1) v += __shfl_xor(v, o);
    return v;
}
#define XB_TMO      128
#define XB_XCNT(j)  (256  + 64 * (j))
#define XB_XSUB(j)  (1280 + 64 * (j))
#define XB_XGEN(j)  (2304 + 64 * (j))
#define XB_TOP      3328
#define XB_TOPGEN   3392
#define XCD_BAR_WORDS 3456
#define XB_SPIN_CAP (1u << 18)

__device__ __forceinline__ unsigned xb_ld(unsigned* p)              { return __hip_atomic_load(p, __ATOMIC_RELAXED, __HIP_MEMORY_SCOPE_AGENT); }
__device__ __forceinline__ unsigned xb_add(unsigned* p, unsigned v) { return __hip_atomic_fetch_add(p, v, __ATOMIC_RELAXED, __HIP_MEMORY_SCOPE_AGENT); }
__device__ __forceinline__ unsigned xb_xcc_id() { return (unsigned)__builtin_amdgcn_s_getreg((3 << 11) | 20) & 0xFu; }
#define XB_SPIN(cond, bar) do { unsigned _sp = 0; while (cond) { __builtin_amdgcn_s_sleep(1); \
    if ((++_sp & 255u) == 0u) { if (xb_ld(&(bar)[XB_TMO])) break; if (_sp > XB_SPIN_CAP) { atomicAdd(&(bar)[XB_TMO], 1u); break; } } } } while (0)

struct XcdBarrier {
    unsigned* bar; unsigned x;
    volatile LAS unsigned* st;
};

__device__ __forceinline__ XcdBarrier xcd_barrier_post(unsigned* bar, volatile LAS unsigned* st) {
    XcdBarrier b; b.bar = bar; b.x = xb_xcc_id(); b.st = st;
    if (threadIdx.x == 0) (void)xb_add(&bar[XB_XCNT(b.x)], 1u);
    return b;
}
__device__ __forceinline__ void xcd_barrier_complete(unsigned* bar, unsigned x, unsigned& nloc, unsigned& nx) {
    const unsigned G = gridDim.x * gridDim.y * gridDim.z;
    unsigned sum, cnt, mine, sp = 0u;
    for (;;) {
        sum = 0u; cnt = 0u; mine = 0u;
#pragma unroll
        for (unsigned j = 0; j < 16; ++j) { const unsigned c = xb_ld(&bar[XB_XCNT(j)]); sum += c; cnt += (c > 0u) ? 1u : 0u; mine = (j == x) ? c : mine; }
        if (sum == G) break;
        __builtin_amdgcn_s_sleep(1);
        if ((++sp & 255u) == 0u) { if (xb_ld(&bar[XB_TMO])) break; if (sp > XB_SPIN_CAP) { atomicAdd(&bar[XB_TMO], 1u); break; } }
    }
    nloc = mine > 0u ? mine : 1u; nx = cnt > 0u ? cnt : 1u;
}

__device__ __forceinline__ void xcd_barrier(const XcdBarrier& b) {
    asm volatile("s_waitcnt vmcnt(0)" ::: "memory");
    __syncthreads();
    if (threadIdx.x == 0) {
        unsigned* bar = b.bar;
        __builtin_amdgcn_s_waitcnt(0);
        unsigned nloc = b.st[0], nx = b.st[1];
        if (nloc == 0u) { xcd_barrier_complete(bar, b.x, nloc, nx); b.st[0] = nloc; b.st[1] = nx; }
        const unsigned old = xb_add(&bar[XB_XSUB(b.x)], 1u);
        const unsigned gen = old / nloc;
        if (old + 1u == (gen + 1u) * nloc) {
            __builtin_amdgcn_fence(__ATOMIC_RELEASE, "agent");
            asm volatile("s_waitcnt vmcnt(0)" ::: "memory");
            const unsigned og = xb_add(&bar[XB_TOP], 1u);
            const unsigned tg = og / nx;
            if (og + 1u == (tg + 1u) * nx) xb_add(&bar[XB_TOPGEN], 1u);
            else XB_SPIN(xb_ld(&bar[XB_TOPGEN]) == tg, bar);
            __builtin_amdgcn_fence(__ATOMIC_ACQUIRE, "agent");
            xb_add(&bar[XB_XGEN(b.x)], 1u);
            asm volatile("s_waitcnt vmcnt(0)" ::: "memory");
        } else {
            XB_SPIN(xb_ld(&bar[XB_XGEN(b.x)]) == gen, bar);
            __builtin_amdgcn_fence(__ATOMIC_ACQUIRE, "agent");
            asm volatile("s_waitcnt vmcnt(0)" ::: "memory");
        }
    }
    __syncthreads();
}

namespace att {
constexpr int KP = 144;
constexpr int OS_PITCH = 144, OS_BYTES = 32 * OS_PITCH;
__device__ __forceinline__ int crow(int r, int hi) { return (r & 3) + 8 * (r >> 2) + 4 * hi; }

struct StageRegs { v4u kr[6], va[3], vb[3]; };
template <int NKEYS>
__device__ __forceinline__ void stage_load(StageRegs& R, const bf16* ksrc, const bf16* vsrc, int pitch, int first_valid, int tid) {
    constexpr int NK = NKEYS * 8 / NTHR, NV = NKEYS * 4 / NTHR;
    const int c = tid & 7, r0 = tid >> 3;
#pragma unroll
    for (int it = 0; it < NK; ++it) { const int row = r0 + it * (NTHR / 8); R.kr[it] = (v4u){0u, 0u, 0u, 0u}; if (row >= first_valid) R.kr[it] = *(const v4u*)(ksrc + (long)row * pitch + 8 * c); }
#pragma unroll
    for (int it = 0; it < NV; ++it) { const int kp = r0 + it * (NTHR / 8); R.va[it] = (v4u){0u, 0u, 0u, 0u}; R.vb[it] = R.va[it];
        if (2 * kp >= first_valid) { R.va[it] = *(const v4u*)(vsrc + (long)(2 * kp) * pitch + 8 * c); R.vb[it] = *(const v4u*)(vsrc + (long)(2 * kp + 1) * pitch + 8 * c); } }
#pragma unroll
    for (int it = NK; it < 6; ++it) R.kr[it] = (v4u){0u, 0u, 0u, 0u};
#pragma unroll
    for (int it = NV; it < 3; ++it) { R.va[it] = (v4u){0u, 0u, 0u, 0u}; R.vb[it] = (v4u){0u, 0u, 0u, 0u}; }
}
template <int NKEYS, int VP>
__device__ __forceinline__ void stage_write(const StageRegs& R, LAS unsigned char* Kl, LAS unsigned char* Vt, const float* gain, int tid) {
    constexpr int NK = NKEYS * 8 / NTHR, NV = NKEYS * 4 / NTHR;
    const int c = tid & 7, r0 = tid >> 3;
    float g[8];
#pragma unroll
    for (int i = 0; i < 8; ++i) g[i] = gain[8 * c + i];
#pragma unroll
    for (int it = 0; it < NK; ++it) {
        const int row = r0 + it * (NTHR / 8);
        float f[8]; unpack8(R.kr[it], f);
        float ss = 0.f;
#pragma unroll
        for (int i = 0; i < 8; ++i) ss += f[i] * f[i];
        ss += __shfl_xor(ss, 1); ss += __shfl_xor(ss, 2); ss += __shfl_xor(ss, 4);
        const float rstd = __builtin_amdgcn_rsqf(ss * (1.0f / 64.0f) + EPS);
#pragma unroll
        for (int i = 0; i < 8; ++i) f[i] = f[i] * rstd * g[i];
        *(LAS v4u*)(Kl + row * KP + 16 * c) = pack8(f);
    }
#pragma unroll
    for (int it = 0; it < NV; ++it) {
        const int kp = r0 + it * (NTHR / 8);
        const v4u a = R.va[it], b = R.vb[it];
        const int q = (2 * kp) & 15, pos = ((q >> 2) & 1) * 8 + (q >> 3) * 4 + (q & 3);
        LAS unsigned char* p = Vt + (8 * c) * VP + 2 * (((2 * kp) & ~15) + pos);
        *(LAS unsigned*)(p + 0 * VP) = (a.x & 0xffffu) | (b.x << 16);
        *(LAS unsigned*)(p + 1 * VP) = (a.x >> 16) | (b.x & 0xffff0000u);
        *(LAS unsigned*)(p + 2 * VP) = (a.y & 0xffffu) | (b.y << 16);
        *(LAS unsigned*)(p + 3 * VP) = (a.y >> 16) | (b.y & 0xffff0000u);
        *(LAS unsigned*)(p + 4 * VP) = (a.z & 0xffffu) | (b.z << 16);
        *(LAS unsigned*)(p + 5 * VP) = (a.z >> 16) | (b.z & 0xffff0000u);
        *(LAS unsigned*)(p + 6 * VP) = (a.w & 0xffffu) | (b.w << 16);
        *(LAS unsigned*)(p + 7 * VP) = (a.w >> 16) | (b.w & 0xffff0000u);
    }
}
struct QRaw { v4u r[4]; };
__device__ __forceinline__ void q_load(QRaw& q, const bf16* Q, int qpitch, int lane) {
    const bf16* qp = Q + (long)(lane & 31) * qpitch + 8 * (lane >> 5);
#pragma unroll
    for (int s = 0; s < 4; ++s) q.r[s] = *(const v4u*)(qp + 16 * s);
}
struct QLine { v4u r[4]; };
__device__ __forceinline__ void q_load_lines(QLine& q, const bf16* Q, int qpitch, int lane) {
    const bf16* qp = Q + (long)(lane >> 3) * qpitch + 8 * (lane & 7);
#pragma unroll
    for (int k = 0; k < 4; ++k) q.r[k] = *(const v4u*)(qp + (long)(8 * k) * qpitch);
}
__device__ __forceinline__ void q_redistribute(const QLine& ql, QRaw& q, LAS unsigned char* stage, int lane) {
#pragma unroll
    for (int k = 0; k < 4; ++k) *(LAS v4u*)(stage + (8 * k + (lane >> 3)) * OS_PITCH + 16 * (lane & 7)) = ql.r[k];
#pragma unroll
    for (int s = 0; s < 4; ++s) q.r[s] = *(const LAS v4u*)(stage + (lane & 31) * OS_PITCH + (2 * s + (lane >> 5)) * 16);
}
__device__ __forceinline__ void q_gains(const float* gq, int lane, f32x4 (&gv)[8]) {
#pragma unroll
    for (int s = 0; s < 4; ++s) { gv[2 * s] = *(const f32x4*)(gq + 16 * s + 8 * (lane >> 5)); gv[2 * s + 1] = *(const f32x4*)(gq + 16 * s + 8 * (lane >> 5) + 4); }
}
__device__ __forceinline__ void q_norm(const QRaw& q, const f32x4 (&gv)[8], int lane, bf16x8 (&qf)[4]) {
    float f[4][8]; float ss = 0.f;
#pragma unroll
    for (int s = 0; s < 4; ++s) { unpack8(q.r[s], f[s]);
#pragma unroll
        for (int j = 0; j < 8; ++j) ss += f[s][j] * f[s][j]; }
    ss += __shfl_xor(ss, 32);
    const float rstd = (0.125f * LOG2E) * __builtin_amdgcn_rsqf(ss * (1.0f / 64.0f) + EPS);
#pragma unroll
    for (int s = 0; s < 4; ++s) {
#pragma unroll
        for (int j = 0; j < 8; ++j) f[s][j] = f[s][j] * rstd * gv[2 * s + (j >> 2)][j & 3];
        qf[s] = __builtin_bit_cast(bf16x8, pack8(f[s]));
    }
}
__device__ __forceinline__ float score_bound2(const float* gq, const float* gk, int lane) {
    float a = fabsf(gq[lane]), b = fabsf(gk[lane]);
#pragma unroll
    for (int o = 1; o < 64; o <<= 1) { a = fmaxf(a, __shfl_xor(a, o)); b = fmaxf(b, __shfl_xor(b, o)); }
    return 8.1f * a * b * LOG2E;
}
template <int NKT, bool SWA, int VP, int NH>
__device__ __forceinline__ void task(LAS const unsigned char* Kl, LAS const unsigned char* Vt, const bf16x8 (&qf)[NH][4],
                                     bf16* const (&O)[NH], int opitch, const float (&slope2)[NH], const float (&sink2)[NH], const float (&shift2)[NH], int kt_first, int lane, LAS unsigned char* oscr) {
    const int ql = lane & 31, hi = lane >> 5;
    int qh = ql - 4 * hi; asm volatile("" : "+v"(qh));
    float base[NH];
#pragma unroll
    for (int h = 0; h < NH; ++h) { base[h] = -shift2[h]; if (SWA) base[h] -= slope2[h] * (float)(qh + 128); }
    const short one = (ql == 0) ? (short)0x3F80 : (short)0;
    const bf16x8 onesf = (bf16x8){one, one, one, one, one, one, one, one};
    constexpr bool ONES = (NH == 1);
    f32x16 Oa[NH][ONES ? 3 : 2]; float vsum[NH];
#pragma unroll
    for (int h = 0; h < NH; ++h) { vsum[h] = 0.f; Oa[h][0] = (f32x16){0.f, 0.f, 0.f, 0.f, 0.f, 0.f, 0.f, 0.f, 0.f, 0.f, 0.f, 0.f, 0.f, 0.f, 0.f, 0.f}; Oa[h][1] = Oa[h][0]; if (ONES) Oa[h][ONES ? 2 : 0] = Oa[h][0]; }
#pragma unroll
    for (int kt = 0; kt < NKT; ++kt) {
        if (SWA && kt < kt_first) continue;
        f32x16 S[NH];
#pragma unroll
        for (int h = 0; h < NH; ++h)
#pragma unroll
            for (int r = 0; r < 16; ++r) {
                const int cr = (r & 3) + 8 * (r >> 2);
                float c = base[h];
                if (SWA) {
                    c = fmaf(slope2[h], (float)(32 * kt + cr), base[h]);
                    if (kt == 0) c = (cr > qh) ? c : -1e30f;
                    if (kt == NKT - 1) c = (cr <= qh) ? c : -1e30f;
                }
                S[h][r] = c;
            }
#pragma unroll
        for (int s = 0; s < 4; ++s) {
            const bf16x8 kf = *(LAS const bf16x8*)(Kl + (32 * kt + ql) * KP + (16 * s + 8 * hi) * 2);
#pragma unroll
            for (int h = 0; h < NH; ++h) S[h] = __builtin_amdgcn_mfma_f32_32x32x16_bf16(kf, qf[h][s], S[h], 0, 0, 0);
        }
#pragma unroll
        for (int h = 0; h < NH; ++h)
#pragma unroll
            for (int r = 0; r < 16; ++r) { S[h][r] = __builtin_amdgcn_exp2f(S[h][r]); if (!ONES) vsum[h] += S[h][r]; }
#pragma unroll
        for (int s = 0; s < 2; ++s) {
            bf16x8 pf[NH];
#pragma unroll
            for (int h = 0; h < NH; ++h) { v4u pw; pw.x = pk2(S[h][8 * s + 0], S[h][8 * s + 1]); pw.y = pk2(S[h][8 * s + 2], S[h][8 * s + 3]);
                pw.z = pk2(S[h][8 * s + 4], S[h][8 * s + 5]); pw.w = pk2(S[h][8 * s + 6], S[h][8 * s + 7]); pf[h] = __builtin_bit_cast(bf16x8, pw); }
#pragma unroll
            for (int dt = 0; dt < 2; ++dt) {
                const bf16x8 vf = *(LAS const bf16x8*)(Vt + (32 * dt + ql) * VP + (32 * kt + 16 * s) * 2 + 16 * hi);
#pragma unroll
                for (int h = 0; h < NH; ++h) Oa[h][dt] = __builtin_amdgcn_mfma_f32_32x32x16_bf16(vf, pf[h], Oa[h][dt], 0, 0, 0);
            }
            if (ONES)
#pragma unroll
                for (int h = 0; h < NH; ++h) Oa[h][ONES ? 2 : 0] = __builtin_amdgcn_mfma_f32_32x32x16_bf16(onesf, pf[h], Oa[h][ONES ? 2 : 0], 0, 0, 0);
        }
        __builtin_amdgcn_sched_barrier(0);
    }
#pragma unroll
    for (int h = 0; h < NH; ++h) {
        float sum = ONES ? Oa[h][ONES ? 2 : 0][0] : vsum[h]; sum += __shfl_xor(sum, 32);
        if (SWA) sum += __builtin_amdgcn_exp2f(sink2[h] - shift2[h]);
        const float inv = 1.0f / sum;
        LAS unsigned char* so = oscr + ql * OS_PITCH + 8 * hi;
#pragma unroll
        for (int dt = 0; dt < 2; ++dt)
#pragma unroll
            for (int rg = 0; rg < 4; ++rg) {
                v2u w; w.x = pk2(Oa[h][dt][4 * rg + 0] * inv, Oa[h][dt][4 * rg + 1] * inv); w.y = pk2(Oa[h][dt][4 * rg + 2] * inv, Oa[h][dt][4 * rg + 3] * inv);
                *(LAS v2u*)(so + 64 * dt + 16 * rg) = w;
            }
        const int rr = lane >> 3, ch = lane & 7;
#pragma unroll
        for (int k = 0; k < 4; ++k) {
            const v4u l = *(const LAS v4u*)(oscr + (8 * k + rr) * OS_PITCH + 16 * ch);
            *(v4u*)(O[h] + (long)(8 * k + rr) * opitch + 8 * ch) = l;
        }
    }
}
constexpr int SWA_VP = 784, MEM_VP = 528;
__device__ __forceinline__ LAS unsigned char* out_stage(LAS unsigned char* lds, int wave) { return lds + ((wave < 5) ? (105472 + wave * OS_BYTES) : (131328 + (wave - 5) * OS_BYTES)); }
constexpr int SWA_VT_OFF = 384 * KP, MEM_VT_OFF = 256 * KP;
}

struct Args { const float* in[19]; float* out; unsigned char* ws; int ph_lo, ph_hi; };

struct MixP { const bf16* PROJ; const bf16* KV; const bf16* MKV; bf16* CAT; const float *knorm, *qnorm, *sinks, *mknorm, *mqnorm; int l; };
__device__ __forceinline__ void unit_load(const MixP& P, int v, int tid, int wave, att::StageRegs& R) {
    asm volatile("" : "+v"(tid));
    const int lane = tid & 63;
    if (v < 512) {
        const int b = v & 7, rem = v >> 3, kvh = rem >> 4, tb = rem & 15;     const long t0 = (long)b * SEQ + tb * 256;
        att::stage_load<384>(R, P.KV + (t0 - 128) * 512 + kvh * 64, P.KV + (t0 - 128) * 512 + 256 + kvh * 64, 512, (tb == 0) ? 128 : 0, tid);
    } else {
        const int u = v - 512, b = u & 7, rem = u >> 3, h = rem >> 3, tb = rem & 7; const long t0 = (long)b * SEQ + tb * 512;
        const bf16* ksrc = P.MKV + (long)(b * MEMLEN) * 2048 + P.l * 512 + h * 64;
        att::stage_load<256>(R, ksrc, ksrc + 256, 2048, 0, tid);
    }
}
__device__ __forceinline__ void unit_write(const MixP& P, int v, LAS unsigned char* lds, int tid, const att::StageRegs& R) {
    asm volatile("" : "+v"(tid));
    if (v < 512) att::stage_write<384, att::SWA_VP>(R, lds, lds + att::SWA_VT_OFF, P.knorm, tid);
    else att::stage_write<256, att::MEM_VP>(R, lds, lds + att::MEM_VT_OFF, P.mknorm + P.l * 64, tid);
}
__device__ __forceinline__ void unit_tasks(const MixP& P, int v, LAS unsigned char* lds, int tid, int wave) {
    asm volatile("" : "+v"(tid));
    const int lane = tid & 63;
    if (v < 512) {
        const int j = P.l - NA;
        const int b = v & 7, rem = v >> 3, kvh = rem >> 4, tb = rem & 15;     const long t0 = (long)b * SEQ + tb * 256;
        const int i = wave;
        att::QLine qcur; att::q_load_lines(qcur, P.PROJ + (t0 + 32 * i) * 1024 + (kvh * 3) * 64, 1024, lane);
        LAS unsigned char* const stage = att::out_stage(lds, wave);
        f32x4 gv[8]; att::q_gains(P.qnorm + j * 64, lane, gv);
        float sk3[3];
#pragma unroll
        for (int g = 0; g < 3; ++g) sk3[g] = P.sinks[j * 12 + kvh * 3 + g];
        const float bound2 = att::score_bound2(P.qnorm + j * 64, P.knorm, lane);
        LAS unsigned char* Kl = lds; LAS unsigned char* Vt = lds + att::SWA_VT_OFF;
        const int kt_first = (tb == 0) ? ((4 - i) > 0 ? (4 - i) : 0) : 0;
#pragma unroll 1
        for (int g = 0; g < 3; ++g) {
            const int hq = kvh * 3 + g;
            int ln = lane; asm volatile("" : "+v"(ln));
            att::QLine qn = qcur;
            if (g < 2) att::q_load_lines(qn, P.PROJ + (t0 + 32 * i) * 1024 + (hq + 1) * 64, 1024, ln);
            att::QRaw qr; att::q_redistribute(qcur, qr, stage, ln);
            bf16x8 qf[1][4]; att::q_norm(qr, gv, ln, qf[0]);
            const float slope2 = exp2f(-8.0f * (float)(hq + 1) / 12.0f) * LOG2E;
            const float sink2 = ((g == 0) ? sk3[0] : (g == 1) ? sk3[1] : sk3[2]) * LOG2E;
            const float shift2 = fmaxf(bound2, sink2);
            bf16* const O1[1] = {P.CAT + (t0 + 32 * i) * 1024 + hq * 64}; const float sl1[1] = {slope2}, sk1[1] = {sink2}, sh1[1] = {shift2};
            att::task<5, true, att::SWA_VP, 1>(Kl + 32 * i * att::KP, Vt + 32 * i * 2, qf, O1, 1024, sl1, sk1, sh1, kt_first, ln, stage);
            qcur = qn;
        }
    } else {
        const int u = v - 512, b = u & 7, rem = u >> 3, h = rem >> 3, tb = rem & 7; const long t0 = (long)b * SEQ + tb * 512;
        att::QLine ql0, ql1;
        att::q_load_lines(ql0, P.PROJ + (t0 + 32 * wave) * 1024 + MAINW + h * 64, 1024, lane);
        att::q_load_lines(ql1, P.PROJ + (t0 + 32 * (wave + 8)) * 1024 + MAINW + h * 64, 1024, lane);
        LAS unsigned char* const stage = att::out_stage(lds, wave);
        f32x4 gv[8]; att::q_gains(P.mqnorm + P.l * 64, lane, gv);
        const float bound2 = att::score_bound2(P.mqnorm + P.l * 64, P.mknorm + P.l * 64, lane);
        LAS unsigned char* Kl = lds; LAS unsigned char* Vt = lds + att::MEM_VT_OFF;
        int ln = lane; asm volatile("" : "+v"(ln));
        att::QRaw q0, q1; att::q_redistribute(ql0, q0, stage, ln); att::q_redistribute(ql1, q1, stage, ln);
        bf16x8 qf[2][4]; att::q_norm(q0, gv, ln, qf[0]); att::q_norm(q1, gv, ln, qf[1]);
        bf16* const cat = P.CAT + (t0 + 32 * wave) * 1024 + MAINW + h * 64;
        bf16* const O2[2] = {cat, cat + (long)256 * 1024};
        const float z2[2] = {0.f, 0.f}, sh2[2] = {bound2, bound2};
        att::task<8, false, att::MEM_VP, 2>(Kl, Vt, qf, O2, 1024, z2, z2, sh2, 0, ln, stage);
    }
}
template <int W>
__device__ __forceinline__ void pool_run(const bf16* up, bf16* dp, int tin) {
    constexpr int RUN = 32;
    v4u ring[W]; float s[8];
#pragma unroll
    for (int i = 0; i < 8; ++i) s[i] = 0.f;
#pragma unroll
    for (int k = 0; k < W; ++k) { ring[k] = (v4u){0u, 0u, 0u, 0u}; if (tin > 0) ring[k] = *(const v4u*)(up - (long)(W - k) * 1024); }
#pragma unroll
    for (int k = 0; k < W; ++k) { float f[8]; unpack8(ring[k], f);
#pragma unroll
        for (int i = 0; i < 8; ++i) s[i] += f[i]; }
#pragma unroll
    for (int tb = 0; tb < RUN; tb += 8) {
        v4u xr[8];
#pragma unroll
        for (int j = 0; j < 8; ++j) xr[j] = *(const v4u*)(up + (long)(tb + j) * 1024);
#pragma unroll
        for (int j = 0; j < 8; ++j) {
            const int t = tb + j;
            float x[8], p[8]; unpack8(xr[j], x); unpack8(ring[t % W], p);
            ring[t % W] = xr[j];
            const float rc = (tin > 0 || t + 1 >= W) ? (1.0f / (float)W) : (1.0f / (float)(t + 1));
            float d[8];
#pragma unroll
            for (int i = 0; i < 8; ++i) { s[i] += x[i] - p[i]; d[i] = s[i] * rc - x[i]; }
            *(v4u*)(dp + (long)t * 1024) = pack8(d);
        }
        asm volatile("" ::: "memory");
    }
}
__device__ __forceinline__ void pool_pass(const bf16* PROJ, bf16* DOUT, int bx, int G, int wave, int lane) {
    if (wave >= 6) return;
    for (int wi = bx * 6 + wave; wi < 4 * 3 * 128; wi += G * 6) {
        int g = wi / 384, rem = wi - g * 384, cb = rem >> 7, rb = rem & 127;
        if (G == 256) {
            const int k = (bx >> 3) * 6 + wave; g = k / 48; const int r2 = k - g * 48; cb = r2 >> 4; rb = (bx & 7) * 16 + (r2 & 15);
        }
        const int run = rb * 8 + (lane >> 3), c = g * 24 + cb * 8 + (lane & 7);
        const long t0 = (long)run * 32; const int tin = (int)(t0 & (SEQ - 1));
        const bf16* up = PROJ + t0 * 1024 + 8 * c; bf16* dp = DOUT + t0 * 1024 + 8 * c;
        if (g == 0) pool_run<2>(up, dp, tin); else if (g == 1) pool_run<4>(up, dp, tin); else if (g == 2) pool_run<8>(up, dp, tin); else pool_run<16>(up, dp, tin);
    }
}

enum { I_X = 0, I_MEM, I_NORM_MIX, I_W_IN, I_POOL_W, I_POOL_SCALE, I_KV_NORM, I_W_KV, I_K_NORM, I_Q_NORM, I_SINKS, I_MEM_NORM, I_W_MEM_KV,
       I_MEM_Q_NORM, I_MEM_K_NORM, I_W_OUT, I_NORM_MLP, I_W_UP, I_W_DOWN };

constexpr int NTR = 2048 + 2048 + 8192 + 8192 + 1024 + 256;
constexpr size_t WS_TMPA = WS_BIG + 128 * MiB, WS_PP = WS_BIG + 136 * MiB;
struct TrD { const float* W; bf16* WT; const float* gk; int ldw, ldt; };
__device__ __forceinline__ void tr_load(const TrD& d, f32x4 (&v)[8], int lane) {
#pragma unroll
    for (int i = 0; i < 8; ++i) v[i] = *(const f32x4*)(d.W + (size_t)(8 * i + (lane >> 3)) * d.ldw + 4 * (lane & 7));
}
__device__ __forceinline__ void tr_store(const TrD& d, const f32x4 (&v)[8], LAS float* scr, int lane) {
#pragma unroll
    for (int i = 0; i < 8; ++i) { LAS float* p = scr + (8 * i + (lane >> 3)) * 33 + 4 * (lane & 7); p[0] = v[i][0]; p[1] = v[i][1]; p[2] = v[i][2]; p[3] = v[i][3]; }
    LDS_WAIT(); asm volatile("" ::: "memory");
    const int c = lane & 7;
    f32x4 g0 = (f32x4){1.f, 1.f, 1.f, 1.f}, g1 = g0;
    if (d.gk) { g0 = *(const f32x4*)(d.gk + 8 * c); g1 = *(const f32x4*)(d.gk + 8 * c + 4); }
#pragma unroll
    for (int j = 0; j < 4; ++j) { const int n = (lane >> 3) + 8 * j; const LAS float* s = scr + (8 * c) * 33 + n;
        v4u o; o.x = pk2(s[0 * 33] * g0[0], s[1 * 33] * g0[1]); o.y = pk2(s[2 * 33] * g0[2], s[3 * 33] * g0[3]); o.z = pk2(s[4 * 33] * g1[0], s[5 * 33] * g1[1]); o.w = pk2(s[6 * 33] * g1[2], s[7 * 33] * g1[3]);
        *(v4u*)(d.WT + (size_t)n * d.ldt + 8 * c) = o; }
    LDS_WAIT(); asm volatile("" ::: "memory");
}
__device__ __forceinline__ void rms_row(const float* xrow, bf16* orow, int lane) {
    const f32x4* xr = (const f32x4*)xrow + lane;
    f32x4 v[4]; float s = 0.f;
#pragma unroll
    for (int j = 0; j < 4; ++j) { v[j] = xr[64 * j]; s += (v[j].x * v[j].x + v[j].y * v[j].y) + (v[j].z * v[j].z + v[j].w * v[j].w); }
    const float rstd = 1.0f / sqrtf(wave_sum(s) * (1.0f / DM) + EPS);
    unsigned long long* o8 = (unsigned long long*)orow + lane;
#pragma unroll
    for (int j = 0; j < 4; ++j) o8[64 * j] = (unsigned long long)pk2(v[j].x * rstd, v[j].y * rstd) | ((unsigned long long)pk2(v[j].z * rstd, v[j].w * rstd) << 32);
}
struct XRows { f32x4 v[2][4]; };
__device__ __forceinline__ void xrows_load(XRows& x, const float* x0, const float* x1, int lane) {
    const f32x4* pa = (const f32x4*)x0 + 2 * lane; const f32x4* pb = (const f32x4*)x1 + 2 * lane;
#pragma unroll
    for (int j = 0; j < 2; ++j) { x.v[0][2 * j] = pa[128 * j]; x.v[0][2 * j + 1] = pa[128 * j + 1]; x.v[1][2 * j] = pb[128 * j]; x.v[1][2 * j + 1] = pb[128 * j + 1]; }
}
__device__ __forceinline__ void xrows_store(const XRows& x, bf16* o0, bf16* o1, float* q0, float* q1, int lane) {
    float ss[2];
#pragma unroll
    for (int r = 0; r < 2; ++r) {
        v4u* op = (v4u*)(r == 0 ? o0 : o1) + lane; float s = 0.f;
#pragma unroll
        for (int j = 0; j < 2; ++j) {
            const f32x4 a = x.v[r][2 * j], b = x.v[r][2 * j + 1];
            v4u w; w.x = pk2(a.x, a.y); w.y = pk2(a.z, a.w); w.z = pk2(b.x, b.y); w.w = pk2(b.z, b.w);
            const float r0 = bf_lo(w.x), r1 = bf_hi(w.x), r2 = bf_lo(w.y), r3 = bf_hi(w.y), r4 = bf_lo(w.z), r5 = bf_hi(w.z), r6 = bf_lo(w.w), r7 = bf_hi(w.w);
            s += ((r0 * r0 + r1 * r1) + (r2 * r2 + r3 * r3)) + ((r4 * r4 + r5 * r5) + (r6 * r6 + r7 * r7));
            op[64 * j] = w;
        }
        ss[r] = wave_sum(s);
    }
    if (lane < 16) { q0[lane] = (lane == 0) ? ss[0] : 0.f; q1[lane] = (lane == 0) ? ss[1] : 0.f; }
}
__device__ __forceinline__ void fold_item(const float* P, const float* scale, const float* Wo, bf16* WT, int item, int lane) {
    const int c0 = (item >> 4) * 8, n = (item & 15) * 64 + lane;
    float acc[8];
#pragma unroll
    for (int j = 0; j < 8; ++j) acc[j] = 0.f;
    for (int d = 0; d < 192; d += 4) {
        const f32x4 sc = *(const f32x4*)(scale + d);
        float w[4];
#pragma unroll
        for (int e = 0; e < 4; ++e) w[e] = Wo[(size_t)(d + e) * DM + n] * sc[e];
#pragma unroll
        for (int j = 0; j < 8; ++j) { const f32x4 p = *(const f32x4*)(P + (c0 + j) * 192 + d); acc[j] += (p[0] * w[0] + p[1] * w[1]) + (p[2] * w[2] + p[3] * w[3]); }
    }
    *(v4u*)(WT + (size_t)n * DM + c0) = pack8(acc);
}

__device__ __forceinline__ void tr_decode(const Args& a, unsigned char* ws, int r, TrD& d) {
    const float* W; bf16* WT; const float* gk = nullptr; int ldw, ldt, nblk, item;
    if (r < 2048) { const int l = r >> 9; item = r & 511; W = a.in[I_W_IN] + (size_t)l * DM * DM; ldw = DM; WT = (bf16*)(ws + WS_WIN + l * 3 * MiB); ldt = DM; nblk = 32; gk = a.in[I_NORM_MIX] + l * DM; }
    else if ((r -= 2048) < 2048) { const int l = r >> 9; item = r & 511;
        W = a.in[I_W_OUT] + (size_t)l * DM * DM; ldw = DM; WT = (bf16*)(ws + WS_WOUT + l * 2 * MiB); ldt = DM; nblk = 32;
        if (l < NA && item < 12 * 32) { WT = (bf16*)(ws + WS_TMPA + l * 2 * MiB); ldt = MAINW; } }
    else if ((r -= 2048) < 8192) { const int l = r >> 11; item = r & 2047; W = a.in[I_W_UP] + (size_t)l * DM * DFF; ldw = DFF; WT = (bf16*)(ws + WS_WUP + l * 8 * MiB); ldt = DM; nblk = 128; gk = a.in[I_NORM_MLP] + l * DM; }
    else if ((r -= 8192) < 8192) { const int l = r >> 11; item = r & 2047; W = a.in[I_W_DOWN] + (size_t)l * DFF * DM; ldw = DM; WT = (bf16*)(ws + WS_WDN + l * 8 * MiB); ldt = DFF; nblk = 32; }
    else if ((r -= 8192) < 1024) { const int l = r >> 8; item = r & 255; W = a.in[I_W_MEM_KV] + (size_t)l * DM * 512; ldw = 512; WT = (bf16*)(ws + WS_WMKV) + (size_t)l * 512 * DM; ldt = DM; nblk = 16; gk = a.in[I_MEM_NORM] + l * DM; }
    else { r -= 1024; item = r; W = a.in[I_W_KV]; ldw = 512; WT = (bf16*)(ws + WS_WIN + 2 * 3 * MiB) + (size_t)1024 * DM; ldt = DM; nblk = 16; gk = a.in[I_KV_NORM]; }
    const int kb = item / nblk, nb = item - kb * nblk, k0 = 64 * kb, n0 = 32 * nb;
    d.W = W + (size_t)k0 * ldw + n0; d.WT = WT + (size_t)n0 * ldt + k0; d.gk = gk ? gk + k0 : nullptr; d.ldw = ldw; d.ldt = ldt;
}
__device__ __forceinline__ void prologue(const Args& a, unsigned char* ws, LAS unsigned char* lds, int gw, int NGW, int lane, int wave) {
    LAS float* scr = (LAS float*)(lds + wave * 16384);
    {
        int it = gw; TrD dc; f32x4 vc[8];
        bool hc = it < NTR;
        if (hc) { tr_decode(a, ws, it, dc); tr_load(dc, vc, lane); }
        while (hc) {
            const int itn = it + NGW; const bool hn = itn < NTR;
            TrD dn = dc; f32x4 vn[8];
#pragma unroll
            for (int i = 0; i < 8; ++i) vn[i] = vc[i];
            if (hn) { tr_decode(a, ws, itn, dn); tr_load(dn, vn, lane); }
            tr_store(dc, vc, scr, lane);
            dc = dn;
#pragma unroll
            for (int i = 0; i < 8; ++i) vc[i] = vn[i];
            hc = hn; it = itn;
        }
    }
    for (int it = gw * 64 + lane; it < 2 * MAINW * (MAINW / 8); it += NGW * 64) {
        const int l = it / (MAINW * (MAINW / 8)), r = it - l * (MAINW * (MAINW / 8)), c = r / (MAINW / 8), ch = r - c * (MAINW / 8), g = c / 192;
        v4u o = (v4u){0u, 0u, 0u, 0u};
        if (ch / 24 == g) { const float* p = a.in[I_POOL_W] + ((size_t)(l * 4 + g) * 192 + (c - g * 192)) * 192 + (8 * ch - g * 192); const float* sc = a.in[I_POOL_SCALE] + l * MAINW + 8 * ch;
            const f32x4 p0 = *(const f32x4*)p, p1 = *(const f32x4*)(p + 4), s0 = *(const f32x4*)sc, s1 = *(const f32x4*)(sc + 4);
            o.x = pk2(p0[0] * s0[0], p0[1] * s0[1]); o.y = pk2(p0[2] * s0[2], p0[3] * s0[3]); o.z = pk2(p1[0] * s1[0], p1[1] * s1[1]); o.w = pk2(p1[2] * s1[2], p1[3] * s1[3]); }
        *(v4u*)((bf16*)(ws + WS_PP + l * 2 * MiB) + (size_t)c * MAINW + 8 * ch) = o;
    }
    for (int m = gw; m < MROWS; m += NGW) rms_row(a.in[I_MEM] + (size_t)m * DM, (bf16*)(ws + WS_MEMN) + (size_t)m * DM, lane);
    {
        int m = gw; XRows xc;
        if (m < M) xrows_load(xc, a.in[I_X] + (size_t)m * DM, a.in[I_X] + (size_t)(m + NGW) * DM, lane);
        while (m < M) {
            const int mn = m + 2 * NGW; XRows xn = xc;
            if (mn < M) xrows_load(xn, a.in[I_X] + (size_t)mn * DM, a.in[I_X] + (size_t)(mn + NGW) * DM, lane);
            xrows_store(xc, (bf16*)(ws + WS_XN) + (size_t)m * DM, (bf16*)(ws + WS_XN) + (size_t)(m + NGW) * DM,
                        (float*)(ws + WS_SSQ + 2 * MiB) + (size_t)m * 16, (float*)(ws + WS_SSQ + 2 * MiB) + (size_t)(m + NGW) * 16, lane);
            xc = xn; m = mn;
        }
    }
}

enum { K_PRO = 0, K_INPROJ, K_MIX, K_OUT, K_UP, K_DOWN };
constexpr int NPHASES = 21;
__device__ __forceinline__ void decode_phase(int ph, int& kind, int& l) {
    if (ph == 0) { kind = K_PRO; l = 0; return; }
    const int p = ph - 1; l = p / 5; const int k = p - 5 * l;
    kind = (k == 0) ? K_INPROJ : (k == 1) ? K_MIX : (k == 2) ? K_OUT : (k == 3) ? K_UP : K_DOWN;
}

__global__ void __launch_bounds__(NTHR, 2) fwd_kernel(Args a) {
    extern __shared__ __attribute__((aligned(16))) unsigned char lds_raw[];
    LAS unsigned char* lds = (LAS unsigned char*)lds_raw;
    volatile LAS unsigned* MISC = (volatile LAS unsigned*)(lds + MISC_OFF);
    if (threadIdx.x < 64) MISC[threadIdx.x] = 0u;
    __syncthreads();
    const int lo = a.ph_lo, hi = a.ph_hi;
    XcdBarrier bar; bar.bar = (unsigned*)(a.ws + WS_CTL); bar.x = 0; bar.st = nullptr;
    if (hi - lo > 1) bar = xcd_barrier_post((unsigned*)(a.ws + WS_CTL), MISC + 8);
    if (lo < 0) { cg::this_grid().sync(); }

    for (int ph = lo; ph < hi; ++ph) {
        int tid = threadIdx.x, bx = blockIdx.x, G = gridDim.x; unsigned long long zo = 0;
        asm volatile("" : "+v"(tid)); asm volatile("" : "+s"(bx), "+s"(G)); asm volatile("" : "+s"(zo));
        unsigned char* ws = a.ws + zo; float* outp = (float*)((unsigned char*)a.out + zo);
        const int lane = tid & 63, wave = __builtin_amdgcn_readfirstlane(tid >> 6);
        const int gw = bx * NWAVES + wave, NGW = G * NWAVES, gthread = bx * NTHR + tid, nthreads = G * NTHR;
        bf16* const XN = (bf16*)(ws + WS_XN);
        bf16* const PROJ = (bf16*)(ws + WS_BIG);
        bf16* const CAT = (bf16*)(ws + WS_BIG + 64 * MiB);
        bf16* const HID = (bf16*)(ws + WS_BIG);
        bf16* const KV = (bf16*)(ws + WS_KV);
        bf16* const MKV = (bf16*)(ws + WS_MKV);
        int kind, l; decode_phase(ph, kind, l);
        float* const SSQ0 = (float*)(ws + WS_SSQ);
        float* const SSQ1 = (float*)(ws + WS_SSQ + 2 * MiB);
        if (kind == K_PRO) {
            prologue(a, ws, lds, gw, NGW, lane, wave);
        } else if (kind == K_MIX) {
            MixP P; P.PROJ = PROJ; P.KV = KV; P.MKV = MKV; P.CAT = CAT; P.knorm = a.in[I_K_NORM]; P.qnorm = a.in[I_Q_NORM]; P.sinks = a.in[I_SINKS];
            P.mknorm = a.in[I_MEM_K_NORM]; P.mqnorm = a.in[I_MEM_Q_NORM]; P.l = l;
            att::StageRegs R;
            int v = (l < NA) ? 512 + bx : bx;
            if (l < NA) pool_pass(PROJ, CAT, bx, G, wave, lane);
            unit_load(P, v, tid, wave, R);
            while (v < 768) {
                unit_write(P, v, lds, tid, R);
                LDS_WAIT(); __syncthreads();
                const int vn = v + G;
                if (v < 512) { if (vn < 768) unit_load(P, vn, tid, wave, R); unit_tasks(P, v, lds, tid, wave); }
                else { unit_tasks(P, v, lds, tid, wave); if (vn < 768) unit_load(P, vn, tid, wave, R); }
                __syncthreads();
                v = vn;
            }
        } else {
            const int ng = (kind == K_INPROJ && l == 0) ? 4 : 1;
            for (int gi = 0; gi < ng; ++gi) {
                pg8::Gemm g; pg8::EpiB E; E.O2 = KV; E.ldc2 = 512; E.split_pn = 1 << 30; E.mode = 0; E.ssq_in = nullptr; E.ssq_out = SSQ0; E.outf = outp; E.scr = lds + EPI_SCR_OFF; g.M = M; g.K = DM;
                int cb = bx;
                if (kind == K_INPROJ && ng == 4 && gi == 0) { g.A = (const bf16*)(ws + WS_MEMN); g.Bt = (const bf16*)(ws + WS_WMKV); g.M = MROWS; g.N = 2048; E.O1 = MKV; E.ldc1 = 2048; }
                else if (kind == K_INPROJ && ng == 4 && gi < 3) {
                    const int fl = gi - 1; g.A = (const bf16*)(ws + WS_TMPA + fl * 2 * MiB); g.Bt = (const bf16*)(ws + WS_PP + fl * 2 * MiB); g.M = DM; g.N = MAINW; g.K = MAINW;
                    E.O1 = (bf16*)(ws + WS_WOUT + fl * 2 * MiB); E.ldc1 = DM; cb = (bx + G - 64 - 12 * fl) % G; }
                else if (kind == K_INPROJ) { g.A = XN; g.Bt = (const bf16*)(ws + WS_WIN + l * 3 * MiB); g.N = (l == 2) ? 1536 : 1024; E.O1 = PROJ; E.ldc1 = 1024; E.split_pn = 4; E.ssq_in = SSQ1; }
                else if (kind == K_OUT) { g.A = CAT; g.Bt = (const bf16*)(ws + WS_WOUT + l * 2 * MiB); g.N = DM; E.O1 = XN; E.ldc1 = DM; E.mode = 2; }
                else if (kind == K_UP) { g.A = XN; g.Bt = (const bf16*)(ws + WS_WUP + l * 8 * MiB); g.N = DFF; E.O1 = HID; E.ldc1 = DFF; E.mode = 1; }
                else { g.A = HID; g.Bt = (const bf16*)(ws + WS_WDN + l * 8 * MiB); g.N = DM; g.K = DFF; E.O1 = XN; E.ldc1 = DM; E.mode = (l == DEPTH - 1) ? 3 : 2; E.ssq_in = SSQ0; E.ssq_out = SSQ1; }
                pg8::StaticOrder S; S.init(g.M, g.N, G, cb);
                pg8::gemm_phase<pg8::EpiB, pg8::StaticOrder, true, true>(lds, g, S, E);
            }
        }
        if (ph + 1 < hi) { bar.bar = (unsigned*)(ws + WS_CTL); xcd_barrier(bar); }
    }
}

#ifndef PER_PHASE_LAUNCH
#define PER_PHASE_LAUNCH 0
#endif
extern "C" void kernel_launch(void* const* d_in, const int* in_sizes, int n_in, void* d_out, int out_size, void* d_ws, size_t ws_size, hipStream_t stream) {
    static int grid = 0;
    if (grid == 0) {
        if (n_in != 19 || out_size != M * DM || ws_size < WS_END) { fprintf(stderr, "kernel_launch: unexpected shapes (n_in %d out %d ws %zu)\n", n_in, out_size, ws_size); grid = -1; return; }
        int dev = 0, cus = 0, per_cu = 0;
        if (hipGetDevice(&dev) != hipSuccess || hipDeviceGetAttribute(&cus, hipDeviceAttributeMultiprocessorCount, dev) != hipSuccess) { grid = -1; return; }
        if (hipFuncSetAttribute((const void*)fwd_kernel, hipFuncAttributeMaxDynamicSharedMemorySize, LDS_BYTES) != hipSuccess) { fprintf(stderr, "kernel_launch: hipFuncSetAttribute failed\n"); grid = -1; return; }
        if (hipOccupancyMaxActiveBlocksPerMultiprocessor(&per_cu, (const void*)fwd_kernel, NTHR, LDS_BYTES) != hipSuccess || per_cu < 1) { fprintf(stderr, "kernel_launch: occupancy query says %d\n", per_cu); per_cu = 1; }
        (void)hipGetLastError();
        grid = cus < 256 ? cus : 256;
    }
    if (grid < 0) return;
    (void)hipMemsetAsync((char*)d_ws + WS_CTL, 0, CTL_BYTES, stream);
    Args a{};
    for (int i = 0; i < 19; ++i) a.in[i] = (const float*)d_in[i];
    a.out = (float*)d_out; a.ws = (unsigned char*)d_ws;
#if PER_PHASE_LAUNCH
    for (int ph = 0; ph < NPHASES; ++ph) {
        a.ph_lo = ph; a.ph_hi = ph + 1;
        hipLaunchKernelGGL(fwd_kernel, dim3(grid), dim3(NTHR), LDS_BYTES, stream, a);
    }
#else
    a.ph_lo = 0; a.ph_hi = NPHASES;
    void* params[] = {&a};
    hipError_t e = hipLaunchCooperativeKernel((const void*)fwd_kernel, dim3(grid), dim3(NTHR), params, LDS_BYTES, stream);
    if (e != hipSuccess) fprintf(stderr, "cooperative launch failed: %s (grid %d)\n", hipGetErrorString(e), grid);
#endif
}
```
